# Optimizing an MI355X kernel written in HIP

```python
import jax, jax.numpy as jnp
from jax import lax
import numpy as np

D_MODEL = 1024
BATCH = 2
SEQ = 8192
DEPTH = 1

N_MEM = 256
XATTN_HEADS = 4
XATTN_HEAD_DIM = D_MODEL // XATTN_HEADS
D_FF = 2816
GLA_HEADS = 4
GLA_DK = 64
GLA_DV = 128
GLA_KEY_W = GLA_HEADS * GLA_DK
GLA_VAL_W = GLA_HEADS * GLA_DV
GATE_RANK = 16
GATE_TAU = 16.0
CHUNK = 64
CONV_W = 512
CONV_K = 3
D_MIX = GLA_VAL_W + CONV_W
EPS = 1e-6
IN_SPLITS = (GLA_KEY_W, GLA_KEY_W, GLA_VAL_W, GLA_VAL_W, GATE_RANK, GATE_RANK,
             CONV_W, CONV_W, CONV_W)
D_IN = sum(IN_SPLITS)

kernel_name = "hybrid_gla_shortconv_macaron_memxattn"


def rms_norm(x, g):
    xf = x.astype(jnp.float32)
    y = xf * lax.rsqrt(jnp.mean(xf * xf, axis=-1, keepdims=True) + EPS)
    return (y * g.astype(jnp.float32)).astype(x.dtype)


def swiglu(h, w_gate, w_up, w_down):
    return (jax.nn.silu(h @ w_gate) * (h @ w_up)) @ w_down


def gla_chunked(q, k, v, g):
    b_, h_, s_, dk = q.shape
    dv = v.shape[-1]
    n = s_ // CHUNK
    q = q.reshape(b_, h_, n, CHUNK, dk)
    k = k.reshape(b_, h_, n, CHUNK, dk)
    v = v.reshape(b_, h_, n, CHUNK, dv)
    bcum = jnp.cumsum(g.reshape(b_, h_, n, CHUNK, dk), axis=3)
    b_last = bcum[:, :, :, -1:, :]
    q_in = q * jnp.exp(bcum)
    k_in = k * jnp.exp(-bcum)
    mask = jnp.tril(jnp.ones((CHUNK, CHUNK), dtype=bool))
    att = jnp.einsum('bhncd,bhnmd->bhncm', q_in, k_in)
    att = jnp.where(mask, att, 0.0)
    o_intra = jnp.einsum('bhncm,bhnmv->bhncv', att, v)
    k_st = k * jnp.exp(b_last - bcum)
    d_state = jnp.einsum('bhncd,bhncv->bhndv', k_st, v)
    decay = jnp.exp(b_last[:, :, :, 0, :])

    def step(state, inp):
        dec, ds = inp
        return dec[..., None] * state + ds, state

    init = jnp.zeros((b_, h_, dk, dv), jnp.float32)
    _, states = lax.scan(step, init, (jnp.moveaxis(decay, 2, 0), jnp.moveaxis(d_state, 2, 0)))
    states = jnp.moveaxis(states, 0, 2)
    o_inter = jnp.einsum('bhncd,bhndv->bhncv', q_in, states)
    return (o_intra + o_inter).reshape(b_, h_, s_, dv)


def low_rank_log_gate(z, w2, b2):
    zf = z.astype(jnp.float32) @ w2.astype(jnp.float32) + b2.astype(jnp.float32)
    lg = jax.nn.log_sigmoid(zf) / GATE_TAU
    bsz, s_ = z.shape[0], z.shape[1]
    return lg.reshape(bsz, s_, GLA_HEADS, GLA_DK).transpose(0, 2, 1, 3)


def to_heads(t, nh):
    bsz, s_, w = t.shape
    return t.reshape(bsz, s_, nh, w // nh).transpose(0, 2, 1, 3)


def token_mixing(h, w_in, gf_w, gf_b, gb_w, gb_b, gla_norm, conv_w, conv_b, w_out):
    bsz, s_, _ = h.shape
    proj = h @ w_in
    idx = np.cumsum(IN_SPLITS)[:-1].tolist()
    q, k, v, r, zf, zb, bg, cg, xv = jnp.split(proj, idx, axis=-1)
    qh = to_heads(q, GLA_HEADS).astype(jnp.float32) * (GLA_DK ** -0.5)
    kh = to_heads(k, GLA_HEADS).astype(jnp.float32)
    vh = to_heads(v, GLA_HEADS).astype(jnp.float32)
    g_fwd = low_rank_log_gate(zf, gf_w, gf_b)
    g_bwd = low_rank_log_gate(zb, gb_w, gb_b)
    o_fwd = gla_chunked(qh, kh, vh, g_fwd)
    flip = lambda t: jnp.flip(t, axis=2)
    o_bwd = flip(gla_chunked(flip(qh), flip(kh), flip(vh), flip(g_bwd)))
    o = o_fwd + o_bwd
    o = o * lax.rsqrt(jnp.mean(o * o, axis=-1, keepdims=True) + EPS)
    o = o * gla_norm.astype(jnp.float32).reshape(GLA_HEADS, 1, GLA_DV)
    o = o.transpose(0, 2, 1, 3).reshape(bsz, s_, GLA_VAL_W).astype(h.dtype)
    a_out = o * jax.nn.silu(r)
    u = cg * xv
    u_prev = jnp.pad(u[:, :-1], ((0, 0), (1, 0), (0, 0)))
    u_next = jnp.pad(u[:, 1:], ((0, 0), (0, 1), (0, 0)))
    conv = conv_w[0] * u_prev + conv_w[1] * u + conv_w[2] * u_next + conv_b
    c_out = bg * conv
    return jnp.concatenate([a_out, c_out], axis=-1) @ w_out


def memory_cross_attention(h, m, w_q, w_kv, w_o):
    q = to_heads(h @ w_q, XATTN_HEADS)
    kv = m @ w_kv
    k, v = jnp.split(kv, 2, axis=-1)
    k = to_heads(k, XATTN_HEADS)
    v = to_heads(v, XATTN_HEADS)
    s = jnp.einsum('bhsd,bhmd->bhsm', q.astype(jnp.float32), k.astype(jnp.float32))
    p = jax.nn.softmax(s * (XATTN_HEAD_DIM ** -0.5), axis=-1)
    o = jnp.einsum('bhsm,bhmd->bhsd', p, v.astype(jnp.float32)).astype(h.dtype)
    bsz, _, s_, _ = o.shape
    o = o.transpose(0, 2, 1, 3).reshape(bsz, s_, D_MODEL)
    return o @ w_o


def setup_inputs(seed: int = 0) -> dict:
    key = jax.random.key(seed)
    ks = iter(jax.random.split(key, 40))

    def dense(shape, fan_in):
        return jax.random.normal(next(ks), shape, jnp.float32) * (fan_in ** -0.5)

    def gain(shape):
        return 1.0 + 0.02 * jax.random.normal(next(ks), shape, jnp.float32)

    def small(shape, scale=0.02, offset=0.0):
        return offset + scale * jax.random.normal(next(ks), shape, jnp.float32)

    L = DEPTH
    return {
        "x": jax.random.normal(next(ks), (BATCH, SEQ, D_MODEL), jnp.float32),
        "mem": jax.random.normal(next(ks), (BATCH, N_MEM, D_MODEL), jnp.float32),
        "ffn1_norm": gain((L, D_MODEL)),
        "ffn1_w_gate": dense((L, D_MODEL, D_FF), D_MODEL),
        "ffn1_w_up": dense((L, D_MODEL, D_FF), D_MODEL),
        "ffn1_w_down": dense((L, D_FF, D_MODEL), D_FF),
        "mix_norm": gain((L, D_MODEL)),
        "w_in": dense((L, D_MODEL, D_IN), D_MODEL),
        "gate_fwd_w": dense((L, GATE_RANK, GLA_KEY_W), GATE_RANK),
        "gate_fwd_b": small((L, GLA_KEY_W), 0.5, 1.0),
        "gate_bwd_w": dense((L, GATE_RANK, GLA_KEY_W), GATE_RANK),
        "gate_bwd_b": small((L, GLA_KEY_W), 0.5, 1.0),
        "gla_norm": gain((L, GLA_VAL_W)),
        "conv_w": dense((L, CONV_K, CONV_W), CONV_K),
        "conv_b": small((L, CONV_W)),
        "w_out": dense((L, D_MIX, D_MODEL), D_MIX),
        "xattn_norm": gain((L, D_MODEL)),
        "mem_norm": gain((L, D_MODEL)),
        "xattn_w_q": dense((L, D_MODEL, D_MODEL), D_MODEL),
        "xattn_w_kv": dense((L, D_MODEL, 2 * D_MODEL), D_MODEL),
        "xattn_w_o": dense((L, D_MODEL, D_MODEL), D_MODEL),
        "ffn2_norm": gain((L, D_MODEL)),
        "ffn2_w_gate": dense((L, D_MODEL, D_FF), D_MODEL),
        "ffn2_w_up": dense((L, D_MODEL, D_FF), D_MODEL),
        "ffn2_w_down": dense((L, D_FF, D_MODEL), D_FF),
        "final_norm": gain((D_MODEL,)),
    }


def reference(x, mem, ffn1_norm, ffn1_w_gate, ffn1_w_up, ffn1_w_down, mix_norm, w_in,
              gate_fwd_w, gate_fwd_b, gate_bwd_w, gate_bwd_b, gla_norm, conv_w, conv_b,
              w_out, xattn_norm, mem_norm, xattn_w_q, xattn_w_kv, xattn_w_o,
              ffn2_norm, ffn2_w_gate, ffn2_w_up, ffn2_w_down, final_norm):
    for l in range(DEPTH):
        x = x + 0.5 * swiglu(rms_norm(x, ffn1_norm[l]), ffn1_w_gate[l], ffn1_w_up[l], ffn1_w_down[l])
        x = x + token_mixing(rms_norm(x, mix_norm[l]), w_in[l], gate_fwd_w[l], gate_fwd_b[l],
                             gate_bwd_w[l], gate_bwd_b[l], gla_norm[l], conv_w[l], conv_b[l], w_out[l])
        x = x + memory_cross_attention(rms_norm(x, xattn_norm[l]), rms_norm(mem, mem_norm[l]),
                                       xattn_w_q[l], xattn_w_kv[l], xattn_w_o[l])
        x = x + 0.5 * swiglu(rms_norm(x, ffn2_norm[l]), ffn2_w_gate[l], ffn2_w_up[l], ffn2_w_down[l])
    return rms_norm(x, final_norm)
```

```cpp
#include <hip/hip_runtime.h>
#include <cstdio>
#include <cstdint>
namespace pg8 {
#define PG8_LAS __attribute__((address_space(3)))
typedef unsigned short bf16_t;
typedef short bf16x8 __attribute__((ext_vector_type(8)));
typedef float f32x4 __attribute__((ext_vector_type(4)));
typedef unsigned u32x4 __attribute__((ext_vector_type(4)));
constexpr int BM = 256, BK = 64, HALF = 128, HTB = HALF * BK * 2  , STAGE_BYTES = 8 * HTB, NXCD = 8, WGM = 8;

__host__ __device__ __forceinline__ int lds_byte(int r, int c) { const int st = (r >> 4) * 2 + (c >> 5), rr = r & 15, cc = c & 31, ob = rr * 64 + cc * 2; return st * 1024 + (ob ^ (((ob >> 9) & 1) << 5)); }
__host__ __device__ __forceinline__ void stage_rc(int b, int& R, int& C) { const int st = b / 1024, sb = b % 1024, swz = sb ^ (((sb >> 9) & 1) << 5); R = (st >> 1) * 16 + swz / 64; C = (st & 1) * 32 + (swz % 64) / 2; }
__host__ __device__ __forceinline__ int perm32(int rho) { const int n = rho >> 4, i = rho & 15; return 8 * (i >> 2) + 4 * n + (i & 3); }

struct Unit { int pm, pn; };
struct Gemm { const bf16_t* A; const bf16_t* Bt; int M, N, K; };

struct StaticOrder {
    int nM, nN, nwg, G, c;
    __host__ __device__ void init(int M, int N, int G_, int c_) { nM = M / BM; nN = N / BM; nwg = nM * nN; G = G_; c = c_; }
    __host__ __device__ bool next(int i, Unit& u) const {
        const long L = (long)i * G + c; if (L >= nwg) return false;
        int wgid = (int)L; { const int q = nwg / NXCD, r = nwg % NXCD, xcd = wgid % NXCD, off = wgid / NXCD; wgid = (xcd < r ? xcd * (q + 1) : r * (q + 1) + (xcd - r) * q) + off; }
        const int nig = WGM * nN, gid = wgid / nig, fm = gid * WGM, gsz = (nM - fm) < WGM ? (nM - fm) : WGM;
        u.pm = fm + ((wgid % nig) % gsz); u.pn = (wgid % nig) / gsz; return true;
    }
    __device__ __forceinline__ void a_ready(const Unit&) const {}
    __device__ __forceinline__ void done(const Unit&) const {}
};

__device__ __forceinline__ unsigned cvt_pk_bf16(float lo, float hi) { unsigned r; asm volatile("v_cvt_pk_bf16_f32 %0, %1, %2" : "=v"(r) : "v"(lo), "v"(hi)); return r; }
template <class Epi, class Sched, bool ALIGN_EPI = false, bool SP2 = false>
__device__ __forceinline__ void gemm_phase(PG8_LAS unsigned char* lds, const Gemm g, const Sched& S, const Epi& E) {
    int tid_l = threadIdx.x; asm volatile("" : "+v"(tid_l));
    const int tid = tid_l, wid = __builtin_amdgcn_readfirstlane(tid >> 6), lane = tid & 63, wr = wid >> 2, wc = wid & 3, fr = lane & 15, fq = lane >> 4;
    const int K = g.K, nt = K / BK;
    unsigned voffA[2], voffB[2];
#pragma unroll
    for (int i = 0; i < 2; ++i) { int R, C; stage_rc(tid * 16 + i * 8192, R, C); const int Rb = Epi::PERM ? ((R & ~31) + perm32(R & 31)) : R;
        voffA[i] = (unsigned)(R * K + C) * 2u; voffB[i] = (unsigned)(Rb * K + C) * 2u; }
    const size_t kstep = (size_t)(BK * 2);
    const size_t hstep = (size_t)HALF * K * 2;
    const size_t tstep = 2 * hstep;
    const unsigned ldsw = (unsigned)wid * 1024u;
    const int aoff = lds_byte(wr * 64 + fr, fq * 8), boff = lds_byte(wc * 32 + fr, fq * 8);
#define PG8_SA(b, h) (((b) * 2 + (h)) * HTB)
#define PG8_SB(b, h) ((4 + (b) * 2 + (h)) * HTB)
#define PG8_STAGE(bufoff, gbase, voff) do { _Pragma("unroll") for (int _i = 0; _i < 2; ++_i) \
        __builtin_amdgcn_global_load_lds((const unsigned*)((const char*)(gbase) + (voff)[_i]), (PG8_LAS unsigned*)(lds + (bufoff) + ldsw + _i * 8192), 16, 0, 0); } while (0)
#define PG8_LDA(dst, b, h) do { _Pragma("unroll") for (int m = 0; m < 4; ++m) _Pragma("unroll") for (int k = 0; k < 2; ++k) dst[m][k] = *(const PG8_LAS bf16x8*)(lds + PG8_SA(b, h) + aoff + m * 2048 + k * 1024); } while (0)
#define PG8_LDB(dst, b, h) do { _Pragma("unroll") for (int n = 0; n < 2; ++n) _Pragma("unroll") for (int k = 0; k < 2; ++k) dst[n][k] = *(const PG8_LAS bf16x8*)(lds + PG8_SB(b, h) + boff + n * 2048 + k * 1024); } while (0)
#define PG8_MMA(ai, bj, At, Bt) do { __builtin_amdgcn_s_setprio(1); _Pragma("unroll") for (int m = 0; m < 4; ++m) _Pragma("unroll") for (int n = 0; n < 2; ++n) _Pragma("unroll") for (int k = 0; k < 2; ++k) \
        acc[ai][bj][m][n] = __builtin_amdgcn_mfma_f32_16x16x32_bf16(Bt[n][k], At[m][k], acc[ai][bj][m][n], 0, 0, 0); __builtin_amdgcn_s_setprio(0); } while (0)
#define PG8_WAIT_V(n) asm volatile("s_waitcnt vmcnt(" #n ")" ::: "memory")
#define PG8_WAIT_L(n) asm volatile("s_waitcnt lgkmcnt(" #n ")" ::: "memory")
#define PG8_BAR __builtin_amdgcn_s_barrier()
#define PG8_SCHED __builtin_amdgcn_sched_barrier(0)
    Unit cur, nxt; int ui = 0;
    if (!S.next(0, cur)) return;
    f32x4 acc[2][2][4][2];
#pragma unroll
    for (int a = 0; a < 2; ++a)
#pragma unroll
        for (int b = 0; b < 2; ++b)
#pragma unroll
            for (int m = 0; m < 4; ++m)
#pragma unroll
                for (int n = 0; n < 2; ++n) acc[a][b][m][n] = (f32x4){0.f, 0.f, 0.f, 0.f};
    bf16x8 At[4][2], B0[2][2], B1[2][2];
    const char* cA = (const char*)g.A + (size_t)cur.pm * tstep; const char* cB = (const char*)g.Bt + (size_t)cur.pn * tstep;
    S.a_ready(cur);
    if constexpr (SP2) {
        PG8_STAGE(PG8_SB(0, 0), cB, voffB); PG8_STAGE(PG8_SB(0, 1), cB + hstep, voffB); PG8_STAGE(PG8_SA(0, 0), cA, voffA); PG8_STAGE(PG8_SA(0, 1), cA + hstep, voffA);
        if (wr == 1) PG8_BAR;
        PG8_WAIT_V(2); PG8_BAR;
        PG8_STAGE(PG8_SB(1, 0), cB + kstep, voffB); PG8_STAGE(PG8_SA(1, 0), cA + kstep, voffA); PG8_STAGE(PG8_SB(1, 1), cB + hstep + kstep, voffB);
        PG8_WAIT_V(6); PG8_BAR;
    } else {
        PG8_STAGE(PG8_SB(0, 0), cB, voffB); PG8_STAGE(PG8_SA(0, 0), cA, voffA); PG8_STAGE(PG8_SB(0, 1), cB + hstep, voffB); PG8_STAGE(PG8_SA(0, 1), cA + hstep, voffA);
        if (wr == 1) PG8_BAR;
        PG8_WAIT_V(4); PG8_BAR;
        PG8_STAGE(PG8_SB(1, 0), cB + kstep, voffB); PG8_STAGE(PG8_SA(1, 0), cA + kstep, voffA); PG8_STAGE(PG8_SB(1, 1), cB + hstep + kstep, voffB);
        PG8_WAIT_V(6); PG8_BAR;
    }
    for (;;) {
        const bool has_next = S.next(ui + 1, nxt);
        const char* nA = has_next ? (const char*)g.A + (size_t)nxt.pm * tstep : cA; const char* nB = has_next ? (const char*)g.Bt + (size_t)nxt.pn * tstep : cB;
        for (int t = 0; t < nt; t += 2) {
            const bool last = (t == nt - 2);
            const char* a1 = cA + (size_t)(t + 1) * kstep;
            const char* a2 = last ? nA : cA + (size_t)(t + 2) * kstep; const char* b2 = last ? nB : cB + (size_t)(t + 2) * kstep;
            const char* a3 = a2 + kstep; const char* b3 = b2 + kstep;
            if (last && has_next) S.a_ready(nxt);
            if constexpr (SP2) {
            PG8_LDB(B0, 0, 0); PG8_LDB(B1, 0, 1); PG8_SCHED; PG8_LDA(At, 0, 0); PG8_STAGE(PG8_SA(1, 1), a1 + hstep, voffA);
            PG8_WAIT_V(8); PG8_WAIT_L(0); PG8_BAR; PG8_MMA(0, 0, At, B0); PG8_MMA(0, 1, At, B1); PG8_BAR; PG8_SCHED;
            PG8_LDA(At, 0, 1); PG8_STAGE(PG8_SB(0, 0), b2, voffB); PG8_STAGE(PG8_SB(0, 1), b2 + hstep, voffB); PG8_STAGE(PG8_SA(0, 0), a2, voffA);
            PG8_WAIT_V(8); PG8_WAIT_L(0); PG8_BAR; PG8_MMA(1, 0, At, B0); PG8_MMA(1, 1, At, B1); PG8_BAR; PG8_SCHED;
            PG8_LDB(B0, 1, 0); PG8_LDB(B1, 1, 1); PG8_SCHED; PG8_LDA(At, 1, 0); PG8_STAGE(PG8_SA(0, 1), a2 + hstep, voffA);
            PG8_WAIT_V(8); PG8_WAIT_L(0); PG8_BAR; PG8_MMA(0, 0, At, B0); PG8_MMA(0, 1, At, B1); PG8_BAR; PG8_SCHED;
            PG8_LDA(At, 1, 1); PG8_STAGE(PG8_SB(1, 0), b3, voffB); PG8_STAGE(PG8_SB(1, 1), b3 + hstep, voffB); PG8_STAGE(PG8_SA(1, 0), a3, voffA);
            PG8_WAIT_V(8); PG8_WAIT_L(0); PG8_BAR; PG8_MMA(1, 0, At, B0); PG8_MMA(1, 1, At, B1); PG8_BAR; PG8_SCHED;
            } else {
            PG8_LDB(B0, 0, 0); PG8_SCHED; PG8_LDA(At, 0, 0); PG8_STAGE(PG8_SA(1, 1), a1 + hstep, voffA);
            PG8_WAIT_L(8); PG8_BAR; PG8_WAIT_L(0); PG8_MMA(0, 0, At, B0); PG8_BAR; PG8_SCHED;
            PG8_LDB(B1, 0, 1); PG8_STAGE(PG8_SB(0, 0), b2, voffB);
            PG8_BAR; PG8_WAIT_L(0); PG8_MMA(0, 1, At, B1); PG8_BAR;
            PG8_LDA(At, 0, 1); PG8_STAGE(PG8_SA(0, 0), a2, voffA);
            PG8_BAR; PG8_WAIT_L(0); PG8_MMA(1, 0, At, B0); PG8_BAR; PG8_SCHED;
            PG8_STAGE(PG8_SB(0, 1), b2 + hstep, voffB);
            PG8_WAIT_V(6); PG8_BAR; PG8_MMA(1, 1, At, B1); PG8_BAR;
            PG8_LDB(B0, 1, 0); PG8_SCHED; PG8_LDA(At, 1, 0); PG8_STAGE(PG8_SA(0, 1), a2 + hstep, voffA);
            PG8_WAIT_L(8); PG8_BAR; PG8_WAIT_L(0); PG8_MMA(0, 0, At, B0); PG8_BAR; PG8_SCHED;
            PG8_LDB(B1, 1, 1); PG8_STAGE(PG8_SB(1, 0), b3, voffB);
            PG8_BAR; PG8_WAIT_L(0); PG8_MMA(0, 1, At, B1); PG8_BAR;
            PG8_LDA(At, 1, 1); PG8_STAGE(PG8_SA(1, 0), a3, voffA);
            PG8_BAR; PG8_WAIT_L(0); PG8_MMA(1, 0, At, B0); PG8_BAR; PG8_SCHED;
            PG8_STAGE(PG8_SB(1, 1), b3 + hstep, voffB);
            PG8_WAIT_V(6); PG8_BAR; PG8_MMA(1, 1, At, B1); PG8_BAR;
            }
        }
        if constexpr (ALIGN_EPI) { if (wr == 0) PG8_BAR; }
        if constexpr (!Epi::AFTER_DRAIN) { E(acc, cur, wr, wc, fr, fq); S.done(cur); }
        if (!has_next) break;
#pragma unroll
        for (int a = 0; a < 2; ++a)
#pragma unroll
            for (int b = 0; b < 2; ++b)
#pragma unroll
                for (int m = 0; m < 4; ++m)
#pragma unroll
                    for (int n = 0; n < 2; ++n) acc[a][b][m][n] = (f32x4){0.f, 0.f, 0.f, 0.f};
        cur = nxt; cA = nA; cB = nB; ++ui;
        if constexpr (ALIGN_EPI) { if (wr == 1) PG8_BAR; }
    }
    PG8_WAIT_V(0);
    if constexpr (!ALIGN_EPI) { if (wr == 0) PG8_BAR; }
    PG8_BAR;
    if constexpr (Epi::AFTER_DRAIN) { E.fused(acc, cur, wr, wc, fr, fq, lds, wid, lane); S.done(cur); }
#undef PG8_SA
#undef PG8_SB
#undef PG8_STAGE
#undef PG8_LDA
#undef PG8_LDB
#undef PG8_MMA
#undef PG8_WAIT_V
#undef PG8_WAIT_L
#undef PG8_BAR
#undef PG8_SCHED
}
}

constexpr int DM = 1024, BATCH = 2, SEQ = 8192, MTOK = BATCH * SEQ, NMEM = 256, DFF = 2816, DIN = 3104, NPROJ = 3072;
constexpr float EPS = 1e-6f;
constexpr size_t MiB = 1u << 20;
constexpr size_t WS_ROWSS = 0;
constexpr size_t WS_Z = 1 * MiB;
constexpr size_t WS_DECAY = 3 * MiB;
constexpr size_t WS_W1CAT = 4 * MiB;
constexpr size_t WS_WD1 = 19 * MiB;
constexpr size_t WS_WIN = 25 * MiB;
constexpr size_t WS_WZ = 31 * MiB;
constexpr size_t WS_WOUT = 32 * MiB, WS_WQ = 34 * MiB, WS_WO = 36 * MiB;
constexpr size_t WS_W2CAT = 38 * MiB;
constexpr size_t WS_WD2 = 49 * MiB;
constexpr size_t WS_KMEM = 55 * MiB;
constexpr size_t WS_VT = 56 * MiB;
constexpr size_t WS_MIX = 58 * MiB;
constexpr size_t WS_R = 90 * MiB;
constexpr size_t WS_XG = 186 * MiB;
constexpr size_t WS_ST = 186 * MiB;
constexpr size_t WS_END = 256 * MiB;
constexpr size_t WS_PART = 256 * 1024;
constexpr size_t WS_BAR = 768 * 1024;
constexpr int LDS_MISC = 135168;
constexpr int LDS_BYTES = LDS_MISC + 64;

#define LAS __attribute__((address_space(3)))
typedef unsigned short bf16;
typedef unsigned v4u __attribute__((ext_vector_type(4)));
typedef unsigned v2u __attribute__((ext_vector_type(2)));
typedef float f32x4 __attribute__((ext_vector_type(4)));
typedef short bf16x8 __attribute__((ext_vector_type(8)));
#define LDS_WAIT() asm volatile("s_waitcnt lgkmcnt(0)" ::: "memory")

typedef float f32x2v __attribute__((ext_vector_type(2)));
typedef __bf16 bf16x2v __attribute__((ext_vector_type(2)));
__device__ __forceinline__ unsigned pk2(float lo, float hi) { const f32x2v v = {lo, hi}; const bf16x2v b = __builtin_convertvector(v, bf16x2v); return __builtin_bit_cast(unsigned, b); }
__device__ __forceinline__ float bflo(unsigned w) { return __uint_as_float(w << 16); }
__device__ __forceinline__ float bfhi(unsigned w) { return __uint_as_float(w & 0xffff0000u); }
__device__ __forceinline__ float silu_f(float x) { return x * __builtin_amdgcn_rcpf(1.f + __expf(-x)); }
__device__ __forceinline__ float logsig_f(float a) { return fminf(a, 0.f) - __logf(1.f + __expf(-fabsf(a))); }
__device__ __forceinline__ float wave_sum(float v) {
#pragma unroll
    for (int o = 1; o < 64; o <<= 1) v += __shfl_xor(v, o);
    return v;
}
__device__ __forceinline__ bf16x8 mk8(unsigned a, unsigned b, unsigned c, unsigned d) { v4u w = {a, b, c, d}; return __builtin_bit_cast(bf16x8, w); }
#define MFMA16(a, b, c) __builtin_amdgcn_mfma_f32_16x16x32_bf16((a), (b), (c), 0, 0, 0)

struct EpiUp {
    static constexpr bool PERM = true, AFTER_DRAIN = false;
    bf16* act; const float* rowss; bf16* Kmem; bf16* VT; int npn_main;
    __device__ __forceinline__ void operator()(const pg8::f32x4 (&acc)[2][2][4][2], const pg8::Unit& u, int wr, int wc, int fr, int fq) const {
        if (u.pn < npn_main) {
            const int row0 = u.pm * 256 + wr * 64 + fr, col0 = u.pn * 128 + wc * 32 + 8 * fq;
            float rsv[2][4];
#pragma unroll
            for (int ai = 0; ai < 2; ++ai)
#pragma unroll
                for (int m = 0; m < 4; ++m) rsv[ai][m] = rowss ? rowss[row0 + ai * 128 + m * 16] : 0.f;
#pragma unroll
            for (int ai = 0; ai < 2; ++ai)
#pragma unroll
                for (int m = 0; m < 4; ++m) {
                    const int r = row0 + ai * 128 + m * 16;
                    const float rs = rowss ? rsqrtf(rsv[ai][m] * (1.f / DM) + EPS) : 1.f;
                    float o[8];
#pragma unroll
                    for (int n = 0; n < 2; ++n)
#pragma unroll
                        for (int i = 0; i < 4; ++i) { const float g = acc[ai][0][m][n][i] * rs, uu = acc[ai][1][m][n][i] * rs; o[n * 4 + i] = silu_f(g) * uu; }
                    v4u w = {pk2(o[0], o[1]), pk2(o[2], o[3]), pk2(o[4], o[5]), pk2(o[6], o[7])};
                    *(v4u*)(act + (size_t)r * DFF + col0) = w;
                }
        } else {
            const int hsel = u.pn - npn_main;
            const int mt0 = (u.pm - MTOK / 256) * 256 + wr * 64 + fr;
#pragma unroll
            for (int ai = 0; ai < 2; ++ai)
#pragma unroll
                for (int m = 0; m < 4; ++m) {
                    const int mt = mt0 + ai * 128 + m * 16, b = mt >> 8, key = mt & 255;
#pragma unroll
                    for (int bj = 0; bj < 2; ++bj) {
                        const int d0 = bj * 128 + wc * 32 + 8 * fq;
                        const f32x4 v0 = acc[ai][bj][m][0], v1 = acc[ai][bj][m][1];
                        if (hsel < 4) {
                            v4u w = {pk2(v0[0], v0[1]), pk2(v0[2], v0[3]), pk2(v1[0], v1[1]), pk2(v1[2], v1[3])};
                            *(v4u*)(Kmem + ((size_t)((b * 4 + hsel) * 256 + key)) * 256 + d0) = w;
                        } else {
                            bf16* dst = VT + ((size_t)((b * 4 + hsel - 4) * 256 + d0)) * 256 + key;
                            const unsigned w0 = pk2(v0[0], v0[1]), w1 = pk2(v0[2], v0[3]), w2 = pk2(v1[0], v1[1]), w3 = pk2(v1[2], v1[3]);
                            dst[0 * 256] = (bf16)(w0 & 0xffffu); dst[1 * 256] = (bf16)(w0 >> 16); dst[2 * 256] = (bf16)(w1 & 0xffffu); dst[3 * 256] = (bf16)(w1 >> 16);
                            dst[4 * 256] = (bf16)(w2 & 0xffffu); dst[5 * 256] = (bf16)(w2 >> 16); dst[6 * 256] = (bf16)(w3 & 0xffffu); dst[7 * 256] = (bf16)(w3 >> 16);
                        }
                    }
                }
        }
    }
};
struct EpiResF {
    static constexpr bool PERM = false, AFTER_DRAIN = false;
    const bf16* base; float* out; float alpha;
    __device__ __forceinline__ void operator()(const pg8::f32x4 (&acc)[2][2][4][2], const pg8::Unit& u, int wr, int wc, int fr, int fq) const {
        const int row0 = u.pm * 256 + wr * 64 + fr, col0 = u.pn * 256 + wc * 32 + 4 * fq;
#pragma unroll
        for (int ai = 0; ai < 2; ++ai)
#pragma unroll
            for (int m = 0; m < 4; ++m) {
                const size_t off = (size_t)(row0 + ai * 128 + m * 16) * DM + col0;
#pragma unroll
                for (int bj = 0; bj < 2; ++bj)
#pragma unroll
                    for (int n = 0; n < 2; ++n) {
                        const v2u bw = *(const v2u*)(base + off + bj * 128 + n * 16);
                        const f32x4 bs = {bflo(bw.x), bfhi(bw.x), bflo(bw.y), bfhi(bw.y)};
                        *(f32x4*)(out + off + bj * 128 + n * 16) = bs + acc[ai][bj][m][n] * alpha;
                    }
            }
    }
};
struct EpiResB {
    static constexpr bool PERM = true, AFTER_DRAIN = false;
    const float* basef; bf16* xs; float* rowss; float alpha;
    __device__ __forceinline__ void operator()(const pg8::f32x4 (&acc)[2][2][4][2], const pg8::Unit& u, int wr, int wc, int fr, int fq) const {
        const int row0 = u.pm * 256 + wr * 64 + fr, col0 = u.pn * 256 + wc * 32 + 8 * fq;
#pragma unroll
        for (int ai = 0; ai < 2; ++ai) {
            f32x4 b0[4][2], b1[4][2];
            if (basef) {
#pragma unroll
                for (int m = 0; m < 4; ++m)
#pragma unroll
                    for (int bj = 0; bj < 2; ++bj) { const float* bp = basef + (size_t)(row0 + ai * 128 + m * 16) * DM + col0 + bj * 128; b0[m][bj] = __builtin_nontemporal_load((const f32x4*)bp); b1[m][bj] = __builtin_nontemporal_load((const f32x4*)(bp + 4));     }
            } else {
                v4u bw[4][2];
#pragma unroll
                for (int m = 0; m < 4; ++m)
#pragma unroll
                    for (int bj = 0; bj < 2; ++bj) bw[m][bj] = *(const v4u*)(xs + (size_t)(row0 + ai * 128 + m * 16) * DM + col0 + bj * 128);
#pragma unroll
                for (int m = 0; m < 4; ++m)
#pragma unroll
                    for (int bj = 0; bj < 2; ++bj) { const v4u w = bw[m][bj]; b0[m][bj] = (f32x4){bflo(w.x), bfhi(w.x), bflo(w.y), bfhi(w.y)}; b1[m][bj] = (f32x4){bflo(w.z), bfhi(w.z), bflo(w.w), bfhi(w.w)}; }
            }
#pragma unroll
            for (int m = 0; m < 4; ++m) {
                const int r = row0 + ai * 128 + m * 16; const size_t off = (size_t)r * DM + col0; float ss = 0.f;
#pragma unroll
                for (int bj = 0; bj < 2; ++bj) {
                    const f32x4 v0 = b0[m][bj] + acc[ai][bj][m][0] * alpha, v1 = b1[m][bj] + acc[ai][bj][m][1] * alpha;
                    ss += ((v0[0] * v0[0] + v0[1] * v0[1]) + (v0[2] * v0[2] + v0[3] * v0[3])) + ((v1[0] * v1[0] + v1[1] * v1[1]) + (v1[2] * v1[2] + v1[3] * v1[3]));
                    *(v4u*)(xs + off + bj * 128) = (v4u){pk2(v0[0], v0[1]), pk2(v0[2], v0[3]), pk2(v1[0], v1[1]), pk2(v1[2], v1[3])};
                }
                ss += __shfl_xor(ss, 16); ss += __shfl_xor(ss, 32); if (fq == 0) atomicAdd(rowss + r, ss);
            }
        }
    }
};
struct EpiScale {
    static constexpr bool PERM = true, AFTER_DRAIN = false;
    bf16* O; int ldc; const float* rowss; float scale; bool nt;
    __device__ __forceinline__ void operator()(const pg8::f32x4 (&acc)[2][2][4][2], const pg8::Unit& u, int wr, int wc, int fr, int fq) const {
        const int row0 = u.pm * 256 + wr * 64 + fr, col0 = u.pn * 256 + wc * 32 + 8 * fq;
        float rsv[2][4];
#pragma unroll
        for (int ai = 0; ai < 2; ++ai)
#pragma unroll
            for (int m = 0; m < 4; ++m) rsv[ai][m] = rowss[row0 + ai * 128 + m * 16];
#pragma unroll
        for (int ai = 0; ai < 2; ++ai)
#pragma unroll
            for (int m = 0; m < 4; ++m) {
                const int r = row0 + ai * 128 + m * 16;
                const float rs = rsqrtf(rsv[ai][m] * (1.f / DM) + EPS) * scale;
#pragma unroll
                for (int bj = 0; bj < 2; ++bj) {
                    const f32x4 v0 = acc[ai][bj][m][0] * rs, v1 = acc[ai][bj][m][1] * rs;
                    v4u w = {pk2(v0[0], v0[1]), pk2(v0[2], v0[3]), pk2(v1[0], v1[1]), pk2(v1[2], v1[3])};
                    if (nt) __builtin_nontemporal_store(w, (v4u*)(O + (size_t)r * ldc + col0 + bj * 128)); else *(v4u*)(O + (size_t)r * ldc + col0 + bj * 128) = w;
                }
            }
    }
};
struct EpiResNorm {
    static constexpr bool PERM = false, AFTER_DRAIN = true;
    const bf16* base; float* out; const float* gain; float alpha; float* part; unsigned* cnt;
    __device__ __forceinline__ void fused(pg8::f32x4 (&acc)[2][2][4][2], const pg8::Unit& u, int wr, int wc, int fr, int fq, PG8_LAS unsigned char* lds, int wid, int lane) const {
        const int row0 = u.pm * 256 + wr * 64 + fr, col0 = u.pn * 256 + wc * 32 + 4 * fq;
        LAS float* P = (LAS float*)lds;
        LAS float* S = (LAS float*)(lds + 4096);
#pragma unroll
        for (int ai = 0; ai < 2; ++ai) {
            v2u bw[4][2][2];
#pragma unroll
            for (int m = 0; m < 4; ++m)
#pragma unroll
                for (int bj = 0; bj < 2; ++bj)
#pragma unroll
                    for (int n = 0; n < 2; ++n) bw[m][bj][n] = *(const v2u*)(base + (size_t)(row0 + ai * 128 + m * 16) * DM + col0 + bj * 128 + n * 16);
#pragma unroll
            for (int m = 0; m < 4; ++m) {
                float ss = 0.f;
#pragma unroll
                for (int bj = 0; bj < 2; ++bj)
#pragma unroll
                    for (int n = 0; n < 2; ++n) {
                        const v2u w = bw[m][bj][n];
                        const f32x4 bs = {bflo(w.x), bfhi(w.x), bflo(w.y), bfhi(w.y)};
                        const f32x4 v = bs + acc[ai][bj][m][n] * alpha;
                        acc[ai][bj][m][n] = v;
                        ss += (v[0] * v[0] + v[1] * v[1]) + (v[2] * v[2] + v[3] * v[3]);
                    }
                ss += __shfl_xor(ss, 16); ss += __shfl_xor(ss, 32);
                if (fq == 0) P[(ai * 128 + wr * 64 + m * 16 + fr) * 4 + wc] = ss;
            }
        }
        __syncthreads();
        const int tid = wid * 64 + lane;
        if (tid < 256) {
            const float t = (P[tid * 4] + P[tid * 4 + 1]) + (P[tid * 4 + 2] + P[tid * 4 + 3]);
            __hip_atomic_store(part + (size_t)(u.pm * 256 + tid) * 4 + u.pn, t, __ATOMIC_RELAXED, __HIP_MEMORY_SCOPE_AGENT);
        }
        asm volatile("s_waitcnt vmcnt(0)" ::: "memory");
        __syncthreads();
        if (tid == 0) {
            __hip_atomic_fetch_add(cnt + 64 * u.pm, 1u, __ATOMIC_RELEASE, __HIP_MEMORY_SCOPE_AGENT);
            unsigned sp = 0;
            while (__hip_atomic_load(cnt + 64 * u.pm, __ATOMIC_RELAXED, __HIP_MEMORY_SCOPE_AGENT) < 4u && ++sp < (1u << 22)) __builtin_amdgcn_s_sleep(2);
            __builtin_amdgcn_fence(__ATOMIC_ACQUIRE, "agent");
        }
        __syncthreads();
        if (tid < 256) {
            const float* pp = part + (size_t)(u.pm * 256 + tid) * 4;
            const float t = (__hip_atomic_load(pp, __ATOMIC_RELAXED, __HIP_MEMORY_SCOPE_AGENT) + __hip_atomic_load(pp + 1, __ATOMIC_RELAXED, __HIP_MEMORY_SCOPE_AGENT))
                          + (__hip_atomic_load(pp + 2, __ATOMIC_RELAXED, __HIP_MEMORY_SCOPE_AGENT) + __hip_atomic_load(pp + 3, __ATOMIC_RELAXED, __HIP_MEMORY_SCOPE_AGENT));
            S[tid] = rsqrtf(t * (1.f / DM) + EPS);
        }
        __syncthreads();
        f32x4 gv[2][2];
#pragma unroll
        for (int bj = 0; bj < 2; ++bj)
#pragma unroll
            for (int n = 0; n < 2; ++n) gv[bj][n] = *(const f32x4*)(gain + col0 + bj * 128 + n * 16);
#pragma unroll
        for (int ai = 0; ai < 2; ++ai)
#pragma unroll
            for (int m = 0; m < 4; ++m) {
                const int rl = ai * 128 + wr * 64 + m * 16 + fr; const float rs = S[rl]; const size_t off = (size_t)(u.pm * 256 + rl) * DM + col0;
#pragma unroll
                for (int bj = 0; bj < 2; ++bj)
#pragma unroll
                    for (int n = 0; n < 2; ++n) { f32x4 ov = acc[ai][bj][m][n] * rs * gv[bj][n];
                        *(f32x4*)(out + off + bj * 128 + n * 16) = ov; }
            }
    }
};
struct OrderUpKV {
    pg8::StaticOrder base; int extra;
    __device__ bool next(int i, pg8::Unit& u) const {
        long L = (long)i * base.G + base.c;
        if (L < base.nwg) return base.next(i, u);
        L -= base.nwg; if (L >= extra) return false;
        u.pm = MTOK / 256 + (int)(L / 8); u.pn = base.nN + (int)(L % 8); return true;
    }
    __device__ __forceinline__ void a_ready(const pg8::Unit&) const {}
    __device__ __forceinline__ void done(const pg8::Unit&) const {}
};

template <int NW>
__device__ __forceinline__ void tr_tile(const float* __restrict__ W, int N, int K, int k0, int n0, bf16* orow0, LAS float* scr, int lane, const float* gain = nullptr) {
    constexpr int LPR = NW / 4, RPI = 64 / LPR, NI = 64 / RPI, STR = NW + 1, NO = NW * 8 / 64;
    const int kr = lane / LPR, nc = (lane % LPR) * 4;
    f32x4 v[NI];
#pragma unroll
    for (int i = 0; i < NI; ++i) v[i] = __builtin_nontemporal_load((const f32x4*)(W + (size_t)(k0 + i * RPI + kr) * N + n0 + nc));
    if (gain) {
#pragma unroll
        for (int i = 0; i < NI; ++i) v[i] = v[i] * gain[k0 + i * RPI + kr];
    }
#pragma unroll
    for (int i = 0; i < NI; ++i) { LAS float* d = scr + (i * RPI + kr) * STR + nc; d[0] = v[i][0]; d[1] = v[i][1]; d[2] = v[i][2]; d[3] = v[i][3]; }
    LDS_WAIT();
#pragma unroll
    for (int j = 0; j < NO; ++j) {
        const int idx = j * 64 + lane, c = idx & 7, n = idx >> 3; const LAS float* sp = scr + (8 * c) * STR + n;
        v4u o; o.x = pk2(sp[0 * STR], sp[1 * STR]); o.y = pk2(sp[2 * STR], sp[3 * STR]); o.z = pk2(sp[4 * STR], sp[5 * STR]); o.w = pk2(sp[6 * STR], sp[7 * STR]);
        *(v4u*)(orow0 + (size_t)n * K + k0 + 8 * c) = o;
    }
    LDS_WAIT();
}
__device__ __forceinline__ void norm_rows2_bf16(const float* x0, const float* x1, const float* gain, bf16* o0, bf16* o1, int lane) {
    const f32x4* xr0 = (const f32x4*)x0 + lane; const f32x4* xr1 = (const f32x4*)x1 + lane; const f32x4* gr = (const f32x4*)gain + lane;
    f32x4 v0[4], v1[4]; float s0 = 0.f, s1 = 0.f;
#pragma unroll
    for (int j = 0; j < 4; ++j) { v0[j] = __builtin_nontemporal_load(xr0 + 64 * j); v1[j] = __builtin_nontemporal_load(xr1 + 64 * j); }
#pragma unroll
    for (int j = 0; j < 4; ++j) { s0 += (v0[j][0] * v0[j][0] + v0[j][1] * v0[j][1]) + (v0[j][2] * v0[j][2] + v0[j][3] * v0[j][3]); s1 += (v1[j][0] * v1[j][0] + v1[j][1] * v1[j][1]) + (v1[j][2] * v1[j][2] + v1[j][3] * v1[j][3]); }
    const float r0 = rsqrtf(wave_sum(s0) * (1.f / DM) + EPS), r1 = rsqrtf(wave_sum(s1) * (1.f / DM) + EPS);
    v2u* p0 = (v2u*)o0 + lane; v2u* p1 = (v2u*)o1 + lane;
#pragma unroll
    for (int j = 0; j < 4; ++j) { const f32x4 gg = gr[64 * j]; const f32x4 t0 = v0[j] * r0 * gg, t1 = v1[j] * r1 * gg;
        p0[64 * j] = (v2u){pk2(t0[0], t0[1]), pk2(t0[2], t0[3])}; p1[64 * j] = (v2u){pk2(t1[0], t1[1]), pk2(t1[2], t1[3])}; }
}

constexpr int GL_STR = 72;
constexpr int GL_A0 = 0, GL_A1 = 9216, GL_A2 = 18432, GL_A3 = 27648, GL_VT = 36864, GL_SS = 36864 + 18432;

struct GlaIn { unsigned short qr[4][4], kr[4][4]; float bw[4]; float bias; f32x4 zv[4]; v4u vraw[2]; };
__device__ __forceinline__ void gla_front_load(GlaIn& R, const float* z, const bf16* proj, const float* gfw, const float* gfb, const float* gbw, const float* gbb,
                                               int b, int h, int n, int tid, int wave, int lane) {
    const int fr = lane & 15, fq = lane >> 4, jt = wave & 3, dir = wave >> 2;
    const int T0 = b * SEQ + n * 64, col = h * 64 + jt * 16 + fr;
    const float* gw = dir ? gbw : gfw; const float* gbias = dir ? gbb : gfb;
#pragma unroll
    for (int tt = 0; tt < 4; ++tt)
#pragma unroll
        for (int i = 0; i < 4; ++i) { const bf16* pr = proj + (size_t)(T0 + tt * 16 + fq * 4 + i) * NPROJ + col; R.qr[tt][i] = pr[0]; R.kr[tt][i] = pr[256]; }
#pragma unroll
    for (int ks = 0; ks < 4; ++ks) R.bw[ks] = gw[(fq * 4 + ks) * 256 + col];
    R.bias = gbias[col];
#pragma unroll
    for (int tt = 0; tt < 4; ++tt) R.zv[tt] = *(const f32x4*)(z + (size_t)(T0 + tt * 16 + fr) * 32 + dir * 16 + fq * 4);
#pragma unroll
    for (int i = 0; i < 2; ++i) { const int cc = tid + 512 * i; R.vraw[i] = *(const v4u*)(proj + (size_t)(T0 + (cc & 63)) * NPROJ + 512 + h * 128 + (cc >> 6) * 8); }
}
template <bool G1>
__device__ __forceinline__ void gla_front_compute(const GlaIn& R, LAS unsigned char* lds, float* decay, int b, int h, int n, int tid, int wave, int lane) {
    const int fr = lane & 15, fq = lane >> 4, jt = wave & 3, dir = wave >> 2, bh = b * 4 + h;
    float g[4][4], c[4][4];
#pragma unroll
    for (int tt = 0; tt < 4; ++tt) {
        f32x4 a = {R.bias, R.bias, R.bias, R.bias};
#pragma unroll
        for (int ks = 0; ks < 4; ++ks) a = __builtin_amdgcn_mfma_f32_16x16x4f32(R.zv[tt][ks], R.bw[ks], a, 0, 0, 0);
#pragma unroll
        for (int i = 0; i < 4; ++i) g[tt][i] = logsig_f(a[i]) * (1.f / 16.f);
    }
    float base = 0.f;
#pragma unroll
    for (int tt = 0; tt < 4; ++tt) {
        const float p0 = g[tt][0], p1 = p0 + g[tt][1], p2 = p1 + g[tt][2], p3 = p2 + g[tt][3];
        const float x1 = __shfl_up(p3, 16), x2 = __shfl_up(p3, 32), x3 = __shfl_up(p3, 48);
        const float excl = (fq >= 1 ? x1 : 0.f) + (fq >= 2 ? x2 : 0.f) + (fq >= 3 ? x3 : 0.f);
        const float ttot = __shfl(excl + p3, 48 + fr);
        const float off = base + excl;
        c[tt][0] = off + p0; c[tt][1] = off + p1; c[tt][2] = off + p2; c[tt][3] = off + p3;
        base += ttot;
    }
    const float total = base;
    if (dir) {
#pragma unroll
        for (int tt = 0; tt < 4; ++tt)
#pragma unroll
            for (int i = 0; i < 4; ++i) c[tt][i] = total - c[tt][i] + g[tt][i];
    }
    if (G1) {
        LAS bf16* KS = (LAS bf16*)(lds + (dir ? GL_A1 : GL_A0));
#pragma unroll
        for (int tt = 0; tt < 4; ++tt) {
            float e[4];
#pragma unroll
            for (int i = 0; i < 4; ++i) e[i] = __uint_as_float((unsigned)R.kr[tt][i] << 16) * __expf(total - c[tt][i]);
            *(LAS v2u*)(KS + (jt * 16 + fr) * GL_STR + tt * 16 + fq * 4) = (v2u){pk2(e[0], e[1]), pk2(e[2], e[3])};
        }
        if (fq == 0) decay[((size_t)(dir * 8 + bh) * 128 + n) * 64 + jt * 16 + fr] = __expf(total);
    } else {
        LAS bf16* Qd = (LAS bf16*)(lds + (dir ? GL_A2 : GL_A0)); LAS bf16* Kd = (LAS bf16*)(lds + (dir ? GL_A3 : GL_A1));
#pragma unroll
        for (int tt = 0; tt < 4; ++tt)
#pragma unroll
            for (int i = 0; i < 4; ++i) {
                const int t = tt * 16 + fq * 4 + i;
                const float q = __uint_as_float((unsigned)R.qr[tt][i] << 16) * 0.125f, k = __uint_as_float((unsigned)R.kr[tt][i] << 16);
                const unsigned w = pk2(q * __expf(c[tt][i]), k * __expf(-c[tt][i]));
                Qd[t * GL_STR + jt * 16 + fr] = (bf16)(w & 0xffffu); Kd[t * GL_STR + jt * 16 + fr] = (bf16)(w >> 16);
            }
    }
    LAS bf16* VTl = (LAS bf16*)(lds + GL_VT);
#pragma unroll
    for (int j = 0; j < 2; ++j) {
        const int cc = tid + 512 * j, t = cc & 63, dvc = cc >> 6;
        const v4u raw = R.vraw[j];
        LAS bf16* dst = VTl + (dvc * 8) * GL_STR + t;
#pragma unroll
        for (int i = 0; i < 8; ++i) dst[i * GL_STR] = (bf16)((i & 1) ? (raw[i >> 1] >> 16) : (raw[i >> 1] & 0xffffu));
    }
}

__device__ __forceinline__ void gla_g1(LAS unsigned char* lds, const float* z, const bf16* proj, const float* gfw, const float* gfb, const float* gbw, const float* gbb,
                                       float* decay, bf16* ST, const float* conv_w, const float* conv_b, bf16* mix, int G, int bid, int tid, int wave, int lane) {
    const int fr = lane & 15, fq = lane >> 4;
    GlaIn R;
    if (bid < 1024) gla_front_load(R, z, proj, gfw, gfb, gbw, gbb, (bid >> 7) >> 2, (bid >> 7) & 3, bid & 127, tid, wave, lane);
    for (int it = bid; it < 1024; it += G) {
        const int bh = it >> 7, n = it & 127, b = bh >> 2, h = bh & 3;
        const int cc0 = h * 128 + (tid & 15) * 8;
        v4u cbg[2], ccg[2][3], cxv[2][3];
#pragma unroll
        for (int i = 0; i < 2; ++i) {
            const int t = b * SEQ + n * 64 + (tid >> 4) + 32 * i;
            const bf16* row = proj + (size_t)t * NPROJ;
            cbg[i] = *(const v4u*)(row + 1536 + cc0); ccg[i][1] = *(const v4u*)(row + 2048 + cc0); cxv[i][1] = *(const v4u*)(row + 2560 + cc0);
            const bool hp = (t & (SEQ - 1)) != 0, hn = (t & (SEQ - 1)) != SEQ - 1;
            ccg[i][0] = (v4u){0, 0, 0, 0}; cxv[i][0] = (v4u){0, 0, 0, 0}; ccg[i][2] = (v4u){0, 0, 0, 0}; cxv[i][2] = (v4u){0, 0, 0, 0};
            if (hp) { ccg[i][0] = *(const v4u*)(row - NPROJ + 2048 + cc0); cxv[i][0] = *(const v4u*)(row - NPROJ + 2560 + cc0); }
            if (hn) { ccg[i][2] = *(const v4u*)(row + NPROJ + 2048 + cc0); cxv[i][2] = *(const v4u*)(row + NPROJ + 2560 + cc0); }
        }
        gla_front_compute<true>(R, lds, decay, b, h, n, tid, wave, lane);
        { const int nx = it + G; if (nx < 1024) gla_front_load(R, z, proj, gfw, gfb, gbw, gbb, (nx >> 7) >> 2, (nx >> 7) & 3, nx & 127, tid, wave, lane); }
        {
            f32x4 w0[2], w1[2], w2[2], cb[2];
#pragma unroll
            for (int q = 0; q < 2; ++q) { w0[q] = *(const f32x4*)(conv_w + cc0 + 4 * q); w1[q] = *(const f32x4*)(conv_w + 512 + cc0 + 4 * q); w2[q] = *(const f32x4*)(conv_w + 1024 + cc0 + 4 * q); cb[q] = *(const f32x4*)(conv_b + cc0 + 4 * q); }
#pragma unroll
            for (int i = 0; i < 2; ++i) {
                const int t = b * SEQ + n * 64 + (tid >> 4) + 32 * i;
                float o[8];
#pragma unroll
                for (int e = 0; e < 8; ++e) {
                    const int w = e >> 1; const bool hi = e & 1;
                    const float up = (hi ? bfhi(ccg[i][0][w]) : bflo(ccg[i][0][w])) * (hi ? bfhi(cxv[i][0][w]) : bflo(cxv[i][0][w]));
                    const float uc = (hi ? bfhi(ccg[i][1][w]) : bflo(ccg[i][1][w])) * (hi ? bfhi(cxv[i][1][w]) : bflo(cxv[i][1][w]));
                    const float un = (hi ? bfhi(ccg[i][2][w]) : bflo(ccg[i][2][w])) * (hi ? bfhi(cxv[i][2][w]) : bflo(cxv[i][2][w]));
                    const float g = hi ? bfhi(cbg[i][w]) : bflo(cbg[i][w]);
                    o[e] = g * (w0[e >> 2][e & 3] * up + w1[e >> 2][e & 3] * uc + w2[e >> 2][e & 3] * un + cb[e >> 2][e & 3]);
                }
                *(v4u*)(mix + (size_t)t * DM + 512 + cc0) = (v4u){pk2(o[0], o[1]), pk2(o[2], o[3]), pk2(o[4], o[5]), pk2(o[6], o[7])};
            }
        }
        __syncthreads();
        const LAS bf16* VTl = (const LAS bf16*)(lds + GL_VT);
        bf16x8 vb[2];
#pragma unroll
        for (int ks = 0; ks < 2; ++ks) vb[ks] = *(const LAS bf16x8*)(VTl + (wave * 16 + fr) * GL_STR + ks * 32 + fq * 8);
#pragma unroll
        for (int dir = 0; dir < 2; ++dir) {
            const LAS bf16* KS = (const LAS bf16*)(lds + (dir ? GL_A1 : GL_A0));
#pragma unroll
            for (int nt = 0; nt < 4; ++nt) {
                f32x4 acc = {0.f, 0.f, 0.f, 0.f};
#pragma unroll
                for (int ks = 0; ks < 2; ++ks) { const bf16x8 ka = *(const LAS bf16x8*)(KS + (nt * 16 + fr) * GL_STR + ks * 32 + fq * 8); acc = MFMA16(ka, vb[ks], acc); }
                *(v2u*)(ST + ((size_t)(dir * 8 + bh) * 128 + n) * 8192 + (wave * 16 + fr) * 64 + nt * 16 + fq * 4) = (v2u){pk2(acc[0], acc[1]), pk2(acc[2], acc[3])};
            }
        }
        __syncthreads();
    }
}

__device__ __forceinline__ void gla_g2(bf16* ST, const float* decay, int G, int bid, int tid) {
    for (int e = bid * 512 + tid; e < 16 * 8192; e += G * 512) {
        const int chain = e >> 13, el = e & 8191, j = el & 63, dir = chain >> 3;
        bf16* base = ST + (size_t)chain * 128 * 8192 + el; const float* dec = decay + (size_t)chain * 128 * 64 + j;
        float S = 0.f;
        for (int s0 = 0; s0 < 128; s0 += 64) {
            float tmp[64], d[64];
#pragma unroll
            for (int u = 0; u < 64; ++u) { const int n = dir ? 127 - (s0 + u) : s0 + u; tmp[u] = __uint_as_float((unsigned)base[(size_t)n * 8192] << 16); d[u] = dec[n * 64]; }
#pragma unroll
            for (int u = 0; u < 64; ++u) { const int n = dir ? 127 - (s0 + u) : s0 + u; base[(size_t)n * 8192] = (bf16)(pk2(S, 0.f) & 0xffffu); S = d[u] * S + tmp[u]; }
        }
    }
}

__device__ __forceinline__ void gla_g3(LAS unsigned char* lds, const float* z, const bf16* proj, const float* gfw, const float* gfb, const float* gbw, const float* gbb,
                                       const bf16* ST, const float* gla_norm, bf16* mix, int G, int bid, int tid, int wave, int lane) {
    const int fr = lane & 15, fq = lane >> 4, tt = wave & 3, dh = wave >> 2;
    GlaIn R;
    if (bid < 1024) gla_front_load(R, z, proj, gfw, gfb, gbw, gbb, (bid >> 7) >> 2, (bid >> 7) & 3, bid & 127, tid, wave, lane);
    for (int it = bid; it < 1024; it += G) {
        const int bh = it >> 7, n = it & 127, b = bh >> 2, h = bh & 3;
        bf16x8 stf[2][4][2]; v2u rr4[4];
#pragma unroll
        for (int dir = 0; dir < 2; ++dir)
#pragma unroll
            for (int dt = 0; dt < 4; ++dt)
#pragma unroll
                for (int ks = 0; ks < 2; ++ks) stf[dir][dt][ks] = *(const bf16x8*)(ST + ((size_t)(dir * 8 + bh) * 128 + n) * 8192 + (size_t)((dh * 4 + dt) * 16 + fr) * 64 + ks * 32 + fq * 8);
#pragma unroll
        for (int dt = 0; dt < 4; ++dt) rr4[dt] = *(const v2u*)(proj + (size_t)(b * SEQ + n * 64 + tt * 16 + fr) * NPROJ + 1024 + h * 128 + (dh * 4 + dt) * 16 + fq * 4);
        gla_front_compute<false>(R, lds, nullptr, b, h, n, tid, wave, lane);
        __syncthreads();
        { const int nx = it + G; if (nx < 1024) gla_front_load(R, z, proj, gfw, gfb, gbw, gbb, (nx >> 7) >> 2, (nx >> 7) & 3, nx & 127, tid, wave, lane); }
        const LAS bf16* VTl = (const LAS bf16*)(lds + GL_VT);
        f32x4 o[4];
#pragma unroll
        for (int dt = 0; dt < 4; ++dt) o[dt] = (f32x4){0.f, 0.f, 0.f, 0.f};
#pragma unroll
        for (int dir = 0; dir < 2; ++dir) {
            const LAS bf16* Qd = (const LAS bf16*)(lds + (dir ? GL_A2 : GL_A0));
            const LAS bf16* Kd = (const LAS bf16*)(lds + (dir ? GL_A3 : GL_A1));
            bf16x8 qfr[2];
#pragma unroll
            for (int ks = 0; ks < 2; ++ks) qfr[ks] = *(const LAS bf16x8*)(Qd + (tt * 16 + fr) * GL_STR + ks * 32 + fq * 8);
            f32x4 at[4];
#pragma unroll
            for (int mt = 0; mt < 4; ++mt) {
                f32x4 a = {0.f, 0.f, 0.f, 0.f};
                const bool live = dir ? (mt >= tt) : (mt <= tt);
                if (live) {
#pragma unroll
                    for (int ks = 0; ks < 2; ++ks) { const bf16x8 kfr = *(const LAS bf16x8*)(Kd + (mt * 16 + fr) * GL_STR + ks * 32 + fq * 8); a = MFMA16(kfr, qfr[ks], a); }
                    if (mt == tt) {
#pragma unroll
                        for (int i = 0; i < 4; ++i) { const int m = fq * 4 + i; const bool keep = dir ? (m >= fr) : (m <= fr); a[i] = keep ? a[i] : 0.f; }
                    }
                }
                at[mt] = a;
            }
            bf16x8 pa[2];
#pragma unroll
            for (int s2 = 0; s2 < 2; ++s2) pa[s2] = mk8(pk2(at[2 * s2][0], at[2 * s2][1]), pk2(at[2 * s2][2], at[2 * s2][3]), pk2(at[2 * s2 + 1][0], at[2 * s2 + 1][1]), pk2(at[2 * s2 + 1][2], at[2 * s2 + 1][3]));
#pragma unroll
            for (int dt = 0; dt < 4; ++dt) {
                const int dvrow = (dh * 4 + dt) * 16 + fr;
#pragma unroll
                for (int s2 = 0; s2 < 2; ++s2) {
                    const v2u lo = *(const LAS v2u*)(VTl + dvrow * GL_STR + s2 * 32 + fq * 4), hi = *(const LAS v2u*)(VTl + dvrow * GL_STR + s2 * 32 + 16 + fq * 4);
                    o[dt] = MFMA16(mk8(lo.x, lo.y, hi.x, hi.y), pa[s2], o[dt]);
                }
#pragma unroll
                for (int ks = 0; ks < 2; ++ks) {
                    o[dt] = MFMA16(stf[dir][dt][ks], qfr[ks], o[dt]);
                }
            }
        }
        float ss = 0.f;
#pragma unroll
        for (int dt = 0; dt < 4; ++dt) ss += (o[dt][0] * o[dt][0] + o[dt][1] * o[dt][1]) + (o[dt][2] * o[dt][2] + o[dt][3] * o[dt][3]);
        ss += __shfl_xor(ss, 16); ss += __shfl_xor(ss, 32);
        LAS float* SS = (LAS float*)(lds + GL_SS);
        if (fq == 0) SS[dh * 64 + tt * 16 + fr] = ss;
        __syncthreads();
        const float tot = SS[tt * 16 + fr] + SS[64 + tt * 16 + fr];
        const float rs = rsqrtf(tot * (1.f / 128.f) + EPS);
        const int tok = b * SEQ + n * 64 + tt * 16 + fr;
#pragma unroll
        for (int dt = 0; dt < 4; ++dt) {
            const int c = h * 128 + (dh * 4 + dt) * 16 + fq * 4;
            const v2u rr = rr4[dt];
            const f32x4 gn = *(const f32x4*)(gla_norm + c);
            const float v0 = o[dt][0] * rs * gn[0] * silu_f(bflo(rr.x)), v1 = o[dt][1] * rs * gn[1] * silu_f(bfhi(rr.x));
            const float v2 = o[dt][2] * rs * gn[2] * silu_f(bflo(rr.y)), v3 = o[dt][3] * rs * gn[3] * silu_f(bfhi(rr.y));
            *(v2u*)(mix + (size_t)tok * DM + c) = (v2u){pk2(v0, v1), pk2(v2, v3)};
        }
    }
}

typedef float f32x16 __attribute__((ext_vector_type(16)));
#define MFMA32(a, b, c) __builtin_amdgcn_mfma_f32_32x32x16_bf16((a), (b), (c), 0, 0, 0)
template <int RS, int NB>
__device__ __forceinline__ void xattn_stage(LAS unsigned char* lds, const bf16* src, int tid) {
    const unsigned char* g = (const unsigned char*)src + (size_t)tid * 16;
    LAS unsigned char* wb = lds + (tid >> 5) * RS + (tid & 31) * 16;
    constexpr int PB = 16 / NB;
#pragma unroll
    for (int hb = 0; hb < NB; ++hb) {
        v4u r[PB];
#pragma unroll
        for (int i = 0; i < PB; ++i) r[i] = *(const v4u*)(g + (hb * PB + i) * 8192);
#pragma unroll
        for (int i = 0; i < PB; ++i) *(LAS v4u*)(wb + (hb * PB + i) * 16 * RS) = r[i];
        asm volatile("" ::: "memory");
    }
}
__device__ __forceinline__ void xattn_stage_load8(v4u (&r)[8], const bf16* src, int tid, int first) {
    const unsigned char* g = (const unsigned char*)src + (size_t)tid * 16;
#pragma unroll
    for (int i = 0; i < 8; ++i) r[i] = *(const v4u*)(g + (first + i) * 8192);
}
template <int RS>
__device__ __forceinline__ void xattn_stage_write8(const v4u (&r)[8], LAS unsigned char* lds, int tid, int first) {
    LAS unsigned char* wb = lds + (tid >> 5) * RS + (tid & 31) * 16;
#pragma unroll
    for (int i = 0; i < 8; ++i) *(LAS v4u*)(wb + (first + i) * 16 * RS) = r[i];
}
__device__ __forceinline__ void xattn_unit(LAS unsigned char* lds, const bf16* QO, bf16* OO, const bf16* Kmem, const bf16* VT, int bh, int qt, int tid, int wave, int lane) {
    const int l31 = lane & 31, hh = lane >> 5, b = bh >> 2, h = bh & 3;
    const int row = b * SEQ + qt * 256 + wave * 32 + l31;
    xattn_stage<528, 1>(lds, Kmem + (size_t)bh * 65536, tid);
    bf16x8 qf[16];
#pragma unroll
    for (int ks = 0; ks < 16; ++ks) qf[ks] = *(const bf16x8*)(QO + (size_t)row * DM + h * 256 + ks * 16 + hh * 8);
    __syncthreads();
    f32x16 st[8];
#pragma unroll
    for (int kt = 0; kt < 8; ++kt) {
        f32x16 a;
#pragma unroll
        for (int i = 0; i < 16; ++i) a[i] = 0.f;
        const LAS unsigned char* kp = lds + (kt * 32 + l31) * 528 + hh * 16;
#pragma unroll
        for (int ks = 0; ks < 16; ++ks) a = MFMA32(*(const LAS bf16x8*)(kp + ks * 32), qf[ks], a);
        st[kt] = a;
        asm volatile("" ::: "memory");
    }
    v4u vpre[8];
    xattn_stage_load8(vpre, VT + (size_t)bh * 65536, tid, 0);
    float mx = -3.0e38f;
#pragma unroll
    for (int kt = 0; kt < 8; ++kt)
#pragma unroll
        for (int i = 0; i < 16; ++i) mx = fmaxf(mx, st[kt][i]);
    mx = fmaxf(mx, __shfl_xor(mx, 32));
    float l = 0.f;
    bf16x8 pb[8][2];
#pragma unroll
    for (int kt = 0; kt < 8; ++kt)
#pragma unroll
        for (int s2 = 0; s2 < 2; ++s2) {
            float pv[8];
#pragma unroll
            for (int j = 0; j < 8; ++j) { pv[j] = __builtin_amdgcn_exp2f(st[kt][8 * s2 + j] - mx); l += pv[j]; }
            pb[kt][s2] = mk8(pk2(pv[0], pv[1]), pk2(pv[2], pv[3]), pk2(pv[4], pv[5]), pk2(pv[6], pv[7]));
        }
    l += __shfl_xor(l, 32);
    const float inv = 1.f / l;
    __syncthreads();
    xattn_stage_write8<520>(vpre, lds, tid, 0);
    { v4u r2[8]; xattn_stage_load8(r2, VT + (size_t)bh * 65536, tid, 8); xattn_stage_write8<520>(r2, lds, tid, 8); }
    __syncthreads();
    bf16* orow = OO + (size_t)row * DM + h * 256;
#pragma unroll 1
    for (int dt = 0; dt < 8; ++dt) {
        f32x16 a;
#pragma unroll
        for (int i = 0; i < 16; ++i) a[i] = 0.f;
        const LAS unsigned char* vp = lds + (dt * 32 + l31) * 520 + hh * 8;
#pragma unroll
        for (int kt = 0; kt < 8; ++kt)
#pragma unroll
            for (int s2 = 0; s2 < 2; ++s2) {
                const v2u lo = *(const LAS v2u*)(vp + (kt * 32 + 16 * s2) * 2), hi = *(const LAS v2u*)(vp + (kt * 32 + 16 * s2 + 8) * 2);
                a = MFMA32(mk8(lo.x, lo.y, hi.x, hi.y), pb[kt][s2], a);
            }
        unsigned w[4][2];
#pragma unroll
        for (int g = 0; g < 4; ++g) { w[g][0] = pk2(a[4 * g] * inv, a[4 * g + 1] * inv); w[g][1] = pk2(a[4 * g + 2] * inv, a[4 * g + 3] * inv); }
#pragma unroll
        for (int k = 0; k < 4; k += 2) {
            const auto r0 = __builtin_amdgcn_permlane32_swap(w[k][0], w[k + 1][0], false, false);
            const auto r1 = __builtin_amdgcn_permlane32_swap(w[k][1], w[k + 1][1], false, false);
            *(v4u*)(orow + dt * 32 + 8 * k + 8 * hh) = (v4u){(unsigned)r0[0], (unsigned)r1[0], (unsigned)r0[1], (unsigned)r1[1]};
        }
    }
    __syncthreads();
}
__device__ __forceinline__ void xattn_phase(LAS unsigned char* lds, const bf16* QO, bf16* OO, const bf16* Kmem, const bf16* VT, int G, int bid, int tid, int wave, int lane) {
    for (int u = bid; u < 256; u += G) xattn_unit(lds, QO, OO, Kmem, VT, u >> 5, u & 31, tid, wave, lane);
}

#define RLX_AGENT __ATOMIC_RELAXED, __HIP_MEMORY_SCOPE_AGENT
#define XB_TMO      128
#define XB_XCNT(j)  (256  + 64 * (j))
#define XB_XSUB(j)  (1280 + 64 * (j))
#define XB_XGEN(j)  (2304 + 64 * (j))
#define XB_TOP      3328
#define XB_TOPGEN   3392
#define XCD_BAR_WORDS 3456
#define XB_SPIN_CAP (1u << 18)

__device__ __forceinline__ unsigned xb_ld(unsigned* p)              { return __hip_atomic_load(p, __ATOMIC_RELAXED, __HIP_MEMORY_SCOPE_AGENT); }
__device__ __forceinline__ unsigned xb_add(unsigned* p, unsigned v) { return __hip_atomic_fetch_add(p, v, __ATOMIC_RELAXED, __HIP_MEMORY_SCOPE_AGENT); }
__device__ __forceinline__ unsigned xb_xcc_id() { return (unsigned)__builtin_amdgcn_s_getreg((3 << 11) | 20) & 0xFu; }
#define XB_SPIN(cond, bar) do { unsigned _sp = 0; while (cond) { __builtin_amdgcn_s_sleep(1); \
    if ((++_sp & 255u) == 0u) { if (xb_ld(&(bar)[XB_TMO])) break; if (_sp > XB_SPIN_CAP) { atomicAdd(&(bar)[XB_TMO], 1u); break; } } } } while (0)

struct XcdBarrier {
    unsigned* bar; unsigned x;
    volatile LAS unsigned* st;
};

__device__ __forceinline__ XcdBarrier xcd_barrier_post(unsigned* bar, volatile LAS unsigned* st) {
    XcdBarrier b; b.bar = bar; b.x = xb_xcc_id(); b.st = st;
    if (threadIdx.x == 0) (void)xb_add(&bar[XB_XCNT(b.x)], 1u);
    return b;
}
__device__ __forceinline__ void xcd_barrier_complete(unsigned* bar, unsigned x, unsigned& nloc, unsigned& nx) {
    const unsigned G = gridDim.x * gridDim.y * gridDim.z;
    unsigned sum, cnt, mine, sp = 0u;
    for (;;) {
        sum = 0u; cnt = 0u; mine = 0u;
#pragma unroll
        for (unsigned j = 0; j < 16; ++j) { const unsigned c = xb_ld(&bar[XB_XCNT(j)]); sum += c; cnt += (c > 0u) ? 1u : 0u; mine = (j == x) ? c : mine; }
        if (sum == G) break;
        __builtin_amdgcn_s_sleep(1);
        if ((++sp & 255u) == 0u) { if (xb_ld(&bar[XB_TMO])) break; if (sp > XB_SPIN_CAP) { atomicAdd(&bar[XB_TMO], 1u); break; } }
    }
    nloc = mine > 0u ? mine : 1u; nx = cnt > 0u ? cnt : 1u;
}

__device__ __forceinline__ void xcd_barrier(const XcdBarrier& b) {
    asm volatile("s_waitcnt vmcnt(0)" ::: "memory");
    __syncthreads();
    if (threadIdx.x == 0) {
        unsigned* bar = b.bar;
        __builtin_amdgcn_s_waitcnt(0);
        unsigned nloc = b.st[0], nx = b.st[1];
        if (nloc == 0u) { xcd_barrier_complete(bar, b.x, nloc, nx); b.st[0] = nloc; b.st[1] = nx; }
        const unsigned old = xb_add(&bar[XB_XSUB(b.x)], 1u);
        const unsigned gen = old / nloc;
        if (old + 1u == (gen + 1u) * nloc) {
            __builtin_amdgcn_fence(__ATOMIC_RELEASE, "agent");
            asm volatile("s_waitcnt vmcnt(0)" ::: "memory");
            const unsigned og = xb_add(&bar[XB_TOP], 1u);
            const unsigned tg = og / nx;
            if (og + 1u == (tg + 1u) * nx) xb_add(&bar[XB_TOPGEN], 1u);
            else XB_SPIN(xb_ld(&bar[XB_TOPGEN]) == tg, bar);
            __builtin_amdgcn_fence(__ATOMIC_ACQUIRE, "agent");
            xb_add(&bar[XB_XGEN(b.x)], 1u);
            asm volatile("s_waitcnt vmcnt(0)" ::: "memory");
        } else {
            XB_SPIN(xb_ld(&bar[XB_TOPGEN]) == gen, bar);
            __builtin_amdgcn_fence(__ATOMIC_ACQUIRE, "agent");
            asm volatile("s_waitcnt vmcnt(0)" ::: "memory");
        }
    }
    __syncthreads();
}

constexpr int I_UP = 16 * 44, I_KV = 16 * 32, I_DN = 44 * 16, I_IN = 16 * 97, I_SQ = 16 * 16;
constexpr int N_EARLY = 2 * I_UP + I_KV + I_DN, N_LATE = I_IN + 3 * I_SQ + 2 * I_UP + I_DN;
struct Params { const float* in[26]; float* out; unsigned char* ws; };


__global__ void __launch_bounds__(512) fwd_kernel(Params p) {
    extern __shared__ __attribute__((aligned(16))) unsigned char lds_raw[];
    LAS unsigned char* lds = (LAS unsigned char*)lds_raw;
#define FRESH_TID() int tid = threadIdx.x; asm volatile("" : "+v"(tid)); const int lane = tid & 63, wave = __builtin_amdgcn_readfirstlane(tid >> 6); (void)lane; (void)wave
    const int G = gridDim.x, bid = blockIdx.x;
    unsigned char* ws = p.ws;
    float* rowss = (float*)(ws + WS_ROWSS); float* zbuf = (float*)(ws + WS_Z); float* decay = (float*)(ws + WS_DECAY);
    bf16* W1CAT = (bf16*)(ws + WS_W1CAT); bf16* WD1 = (bf16*)(ws + WS_WD1); bf16* WIN = (bf16*)(ws + WS_WIN); bf16* WZ = (bf16*)(ws + WS_WZ);
    bf16* WOUT = (bf16*)(ws + WS_WOUT); bf16* WQ = (bf16*)(ws + WS_WQ); bf16* WO = (bf16*)(ws + WS_WO); bf16* W2CAT = (bf16*)(ws + WS_W2CAT); bf16* WD2 = (bf16*)(ws + WS_WD2);
    bf16* KMEM = (bf16*)(ws + WS_KMEM); bf16* VTM = (bf16*)(ws + WS_VT); bf16* MIX = (bf16*)(ws + WS_MIX); bf16* RB = (bf16*)(ws + WS_R); bf16* XG = (bf16*)(ws + WS_XG);
    bf16* ST = (bf16*)p.out;
    const float* x = p.in[0]; float* out = p.out;
    volatile LAS unsigned* MISC = (volatile LAS unsigned*)(lds + LDS_MISC);
    if (threadIdx.x < 16) MISC[threadIdx.x] = 0u;
    __syncthreads();
    const XcdBarrier xbar = xcd_barrier_post((unsigned*)(ws + WS_BAR), MISC);

    {
        FRESH_TID();
        LAS float* scr = (LAS float*)(lds + wave * 16896);
        const int gw = bid * 8 + wave, NGW = G * 8;
        for (int it = gw; it < N_EARLY; it += NGW) {
            int r = it;
            if (r < I_UP) { const int kb = r / 44, n0 = (r % 44) * 64; tr_tile<64>(p.in[3], DFF, DM, kb * 64, n0, W1CAT + (size_t)((n0 >> 7) * 256 + (n0 & 127)) * DM, scr, lane); continue; } r -= I_UP;
            if (r < I_UP) { const int kb = r / 44, n0 = (r % 44) * 64; tr_tile<64>(p.in[4], DFF, DM, kb * 64, n0, W1CAT + (size_t)((n0 >> 7) * 256 + 128 + (n0 & 127)) * DM, scr, lane); continue; } r -= I_UP;
            if (r < I_KV) { const int kb = r / 32, n0 = (r % 32) * 64; tr_tile<64>(p.in[19], 2 * DM, DM, kb * 64, n0, W1CAT + (size_t)(2 * DFF + n0) * DM, scr, lane); continue; } r -= I_KV;
            { const int kb = r / 16, n0 = (r % 16) * 64; tr_tile<64>(p.in[5], DM, DFF, kb * 64, n0, WD1 + (size_t)n0 * DFF, scr, lane); }
        }
        for (int m = gw * 2; m < MTOK + BATCH * NMEM; m += NGW * 2) {
            if (m < MTOK) norm_rows2_bf16(x + (size_t)m * DM, x + (size_t)(m + 1) * DM, p.in[2], XG + (size_t)m * DM, XG + (size_t)(m + 1) * DM, lane);
            else norm_rows2_bf16(p.in[1] + (size_t)(m - MTOK) * DM, p.in[1] + (size_t)(m + 1 - MTOK) * DM, p.in[17], XG + (size_t)m * DM, XG + (size_t)(m + 1) * DM, lane);
        }
        for (int i = bid * 512 + tid; i < 3 * MTOK; i += G * 512) rowss[i] = 0.f;
    }
    xcd_barrier(xbar);

    {
        pg8::Gemm g{XG, W1CAT, MTOK + 512, 2 * DFF + 2 * DM, DM};
        OrderUpKV S; S.base.init(MTOK, 2 * DFF, G, bid); S.extra = 16;
        EpiUp E{RB, nullptr, KMEM, VTM, 2 * DFF / 256};
        pg8::gemm_phase<EpiUp, OrderUpKV, true, true>(lds, g, S, E);
        constexpr int NU = 2 * DFF / 256 * (MTOK / 256) + 16;
        const int rem = NU % G, nsp = rem ? G - rem : G, si = rem ? bid - rem : bid;
        if (si >= 0) {
            FRESH_TID();
            LAS float* scr = (LAS float*)(lds + wave * 16896);
            for (int it = si * 8 + wave; it < N_LATE; it += nsp * 8) {
                int r = it;
                if (r < I_IN) { const int kb = r / 97, nb = r % 97, n0 = nb * 32;
                    bf16* dst = nb < 48 ? WIN + (size_t)n0 * DM : (nb == 48 ? WZ : WIN + (size_t)(n0 - 32) * DM);
                    tr_tile<32>(p.in[7], DIN, DM, kb * 64, n0, dst, scr, lane, p.in[6]); continue; } r -= I_IN;
                if (r < I_SQ) { const int kb = r / 16, n0 = (r % 16) * 64; tr_tile<64>(p.in[15], DM, DM, kb * 64, n0, WOUT + (size_t)n0 * DM, scr, lane); continue; } r -= I_SQ;
                if (r < I_SQ) { const int kb = r / 16, n0 = (r % 16) * 64; tr_tile<64>(p.in[18], DM, DM, kb * 64, n0, WQ + (size_t)n0 * DM, scr, lane, p.in[16]); continue; } r -= I_SQ;
                if (r < I_SQ) { const int kb = r / 16, n0 = (r % 16) * 64; tr_tile<64>(p.in[20], DM, DM, kb * 64, n0, WO + (size_t)n0 * DM, scr, lane); continue; } r -= I_SQ;
                if (r < I_UP) { const int kb = r / 44, n0 = (r % 44) * 64; tr_tile<64>(p.in[22], DFF, DM, kb * 64, n0, W2CAT + (size_t)((n0 >> 7) * 256 + (n0 & 127)) * DM, scr, lane, p.in[21]); continue; } r -= I_UP;
                if (r < I_UP) { const int kb = r / 44, n0 = (r % 44) * 64; tr_tile<64>(p.in[23], DFF, DM, kb * 64, n0, W2CAT + (size_t)((n0 >> 7) * 256 + 128 + (n0 & 127)) * DM, scr, lane, p.in[21]); continue; } r -= I_UP;
                { const int kb = r / 16, n0 = (r % 16) * 64; tr_tile<64>(p.in[24], DM, DFF, kb * 64, n0, WD2 + (size_t)n0 * DFF, scr, lane); }
            }
        }
    }
    xcd_barrier(xbar);
    {
        pg8::Gemm g{RB, WD1, MTOK, DM, DFF};
        pg8::StaticOrder S; S.init(MTOK, DM, G, bid);
        EpiResB E{x, XG, rowss, 0.5f};
        pg8::gemm_phase<EpiResB, pg8::StaticOrder, true, true>(lds, g, S, E);
    }
    xcd_barrier(xbar);
    {
        {
        pg8::Gemm g{XG, WIN, MTOK, NPROJ, DM};
        pg8::StaticOrder S; S.init(MTOK, NPROJ, G, bid);
        EpiScale E{RB, NPROJ, rowss, 1.f, true};
        pg8::gemm_phase<EpiScale, pg8::StaticOrder, true, true>(lds, g, S, E);
        }
        FRESH_TID();
        const int fr = lane & 15, fq = lane >> 4;
        for (int rb = bid; rb < MTOK / 64; rb += G) {
            const int row0 = rb * 64 + (wave >> 1) * 16, zc0 = (wave & 1) * 16;
            f32x4 acc0 = {0.f, 0.f, 0.f, 0.f}, acc1 = {0.f, 0.f, 0.f, 0.f};
            const float rsq = rowss[row0 + fr];
#pragma unroll 1
            for (int half = 0; half < 2; ++half) {
                v4u rg[12];
#pragma unroll
                for (int i = 0; i < 12; ++i) {
                    const int c = tid + 512 * i, row = c >> 6, c16 = c & 63;
                    const bf16* src = (row < 64 ? XG + (size_t)(rb * 64 + row) * DM : WZ + (size_t)(row - 64) * DM) + half * 512 + c16 * 8;
                    rg[i] = *(const v4u*)src;
                }
#pragma unroll
                for (int i = 0; i < 12; ++i) { const int c = tid + 512 * i; *(LAS v4u*)(lds + (c >> 6) * 1040 + (c & 63) * 16) = rg[i]; }
                __syncthreads();
                const LAS unsigned char* ap = lds + (64 + zc0 + fr) * 1040 + fq * 16; const LAS unsigned char* bp = lds + ((wave >> 1) * 16 + fr) * 1040 + fq * 16;
#pragma unroll
                for (int i = 0; i < 16; i += 2) {
                    acc0 = MFMA16(*(const LAS bf16x8*)(ap + i * 64), *(const LAS bf16x8*)(bp + i * 64), acc0);
                    acc1 = MFMA16(*(const LAS bf16x8*)(ap + (i + 1) * 64), *(const LAS bf16x8*)(bp + (i + 1) * 64), acc1);
                }
                __syncthreads();
            }
            const float rs = rsqrtf(rsq * (1.f / DM) + EPS);
            *(f32x4*)(zbuf + (size_t)(row0 + fr) * 32 + zc0 + fq * 4) = (acc0 + acc1) * rs;
        }
    }
    xcd_barrier(xbar);
    { FRESH_TID(); gla_g1(lds, zbuf, RB, p.in[8], p.in[9], p.in[10], p.in[11], decay, ST, p.in[13], p.in[14], MIX, G, bid, tid, wave, lane); }
    xcd_barrier(xbar);
    { FRESH_TID(); gla_g2(ST, decay, G, bid, tid); }
    xcd_barrier(xbar);
    { FRESH_TID(); gla_g3(lds, zbuf, RB, p.in[8], p.in[9], p.in[10], p.in[11], ST, p.in[12], MIX, G, bid, tid, wave, lane); }
    xcd_barrier(xbar);
    {
        pg8::Gemm g{MIX, WOUT, MTOK, DM, DM};
        pg8::StaticOrder S; S.init(MTOK, DM, G, bid);
        EpiResB E{nullptr, XG, rowss + MTOK, 1.f};
        pg8::gemm_phase<EpiResB, pg8::StaticOrder, true, true>(lds, g, S, E);
    }
    xcd_barrier(xbar);
    {
        pg8::Gemm g{XG, WQ, MTOK, DM, DM};
        pg8::StaticOrder S; S.init(MTOK, DM, G, bid);
        EpiScale E{MIX, DM, rowss + MTOK, 0.0625f * 1.4426950408889634f, false};
        pg8::gemm_phase<EpiScale, pg8::StaticOrder, true, true>(lds, g, S, E);
    }
    xcd_barrier(xbar);
    { FRESH_TID(); xattn_phase(lds, MIX, RB, KMEM, VTM, G, bid, tid, wave, lane); }
    xcd_barrier(xbar);
    {
        pg8::Gemm g{RB, WO, MTOK, DM, DM};
        pg8::StaticOrder S; S.init(MTOK, DM, G, bid);
        EpiResB E{nullptr, XG, rowss + 2 * MTOK, 1.f};
        pg8::gemm_phase<EpiResB, pg8::StaticOrder, true, true>(lds, g, S, E);
    }
    xcd_barrier(xbar);
    {
        pg8::Gemm g{XG, W2CAT, MTOK, 2 * DFF, DM};
        pg8::StaticOrder S; S.init(MTOK, 2 * DFF, G, bid);
        EpiUp E{RB, rowss + 2 * MTOK, nullptr, nullptr, 2 * DFF / 256};
        pg8::gemm_phase<EpiUp, pg8::StaticOrder, true, true>(lds, g, S, E);
    }
    xcd_barrier(xbar);
    if (G == MTOK / 256 * (DM / 256)) {
        pg8::Gemm g{RB, WD2, MTOK, DM, DFF};
        pg8::StaticOrder S; S.init(MTOK, DM, G, bid);
        EpiResNorm E{XG, out, p.in[25], 0.5f, (float*)(ws + WS_PART), (unsigned*)(ws + WS_BAR + 16384)};
        pg8::gemm_phase<EpiResNorm, pg8::StaticOrder, false, true>(lds, g, S, E);
    } else {
        {
            pg8::Gemm g{RB, WD2, MTOK, DM, DFF};
            pg8::StaticOrder S; S.init(MTOK, DM, G, bid);
            EpiResF E{XG, out, 0.5f};
            pg8::gemm_phase<EpiResF, pg8::StaticOrder, true, true>(lds, g, S, E);
        }
        xcd_barrier(xbar);
        {
            FRESH_TID();
            const int gw = bid * 8 + wave, NGW = G * 8;
            for (int m = gw; m < MTOK; m += NGW) {
                f32x4* xr = (f32x4*)(out + (size_t)m * DM) + lane; const f32x4* gr = (const f32x4*)p.in[25] + lane;
                f32x4 v[4]; float s = 0.f;
#pragma unroll
                for (int j = 0; j < 4; ++j) { v[j] = xr[64 * j]; s += (v[j][0] * v[j][0] + v[j][1] * v[j][1]) + (v[j][2] * v[j][2] + v[j][3] * v[j][3]); }
                const float rs = rsqrtf(wave_sum(s) * (1.f / DM) + EPS);
#pragma unroll
                for (int j = 0; j < 4; ++j) xr[64 * j] = v[j] * rs * gr[64 * j];
            }
        }
    }
}

extern "C" void kernel_launch(void* const* d_in, const int* in_sizes, int n_in, void* d_out, int out_size, void* d_ws, size_t ws_size, hipStream_t stream) {
    static int grid_blocks = 0;
    if (!grid_blocks) {
        if (n_in != 26 || out_size != MTOK * DM || ws_size < WS_END) { fprintf(stderr, "kernel_launch: unexpected shapes n_in=%d out=%d ws=%zu\n", n_in, out_size, ws_size); grid_blocks = -1; return; }
        int dev = 0, cus = 0, per_cu = 0;
        hipGetDevice(&dev);
        hipDeviceGetAttribute(&cus, hipDeviceAttributeMultiprocessorCount, dev);
        hipFuncSetAttribute((const void*)fwd_kernel, hipFuncAttributeMaxDynamicSharedMemorySize, LDS_BYTES);
        hipOccupancyMaxActiveBlocksPerMultiprocessor(&per_cu, (const void*)fwd_kernel, 512, LDS_BYTES);
        if (per_cu < 1) { fprintf(stderr, "kernel_launch: occupancy query says %d blocks/CU\n", per_cu); per_cu = 1; }
        grid_blocks = cus * per_cu;
    }
    if (grid_blocks < 0) return;
    if (hipMemsetAsync((char*)d_ws + WS_BAR, 0, 32768, stream) != hipSuccess) { fprintf(stderr, "kernel_launch: memset failed\n"); return; }
    Params p{};
    for (int i = 0; i < 26; ++i) p.in[i] = (const float*)d_in[i];
    p.out = (float*)d_out; p.ws = (unsigned char*)d_ws;
    void* args[] = {&p};
    hipError_t e = hipLaunchCooperativeKernel((const void*)fwd_kernel, dim3(grid_blocks), dim3(512), args, LDS_BYTES, stream);
    if (e != hipSuccess) fprintf(stderr, "cooperative launch failed: %s (grid %d)\n", hipGetErrorString(e), grid_blocks);
}
```

```cpp
#include <hip/hip_runtime.h>
#include <cstdio>
#include <cstdint>
namespace pg8 {
#define PG8_LAS __attribute__((address_space(3)))
typedef unsigned short bf16_t;
typedef short bf16x8 __attribute__((ext_vector_type(8)));
typedef float f32x4 __attribute__((ext_vector_type(4)));
typedef unsigned u32x4 __attribute__((ext_vector_type(4)));
constexpr int BM = 256, BK = 64, HALF = 128, HTB = HALF * BK * 2  , STAGE_BYTES = 8 * HTB, NXCD = 8, WGM = 8;

__host__ __device__ __forceinline__ int lds_byte(int r, int c) { const int st = (r >> 4) * 2 + (c >> 5), rr = r & 15, cc = c & 31, ob = rr * 64 + cc * 2; return st * 1024 + (ob ^ (((ob >> 9) & 1) << 5)); }
__host__ __device__ __forceinline__ void stage_rc(int b, int& R, int& C) { const int st = b / 1024, sb = b % 1024, swz = sb ^ (((sb >> 9) & 1) << 5); R = (st >> 1) * 16 + swz / 64; C = (st & 1) * 32 + (swz % 64) / 2; }
__host__ __device__ __forceinline__ int perm32(int rho) { const int n = rho >> 4, i = rho & 15; return 8 * (i >> 2) + 4 * n + (i & 3); }

struct Unit { int pm, pn; };
struct Gemm { const bf16_t* A; const bf16_t* Bt; int M, N, K; };

struct StaticOrder {
    int nM, nN, nwg, G, c;
    __host__ __device__ void init(int M, int N, int G_, int c_) { nM = M / BM; nN = N / BM; nwg = nM * nN; G = G_; c = c_; }
    __host__ __device__ bool next(int i, Unit& u) const {
        const long L = (long)i * G + c; if (L >= nwg) return false;
        int wgid = (int)L; { const int q = nwg / NXCD, r = nwg % NXCD, xcd = wgid % NXCD, off = wgid / NXCD; wgid = (xcd < r ? xcd * (q + 1) : r * (q + 1) + (xcd - r) * q) + off; }
        const int nig = WGM * nN, gid = wgid / nig, fm = gid * WGM, gsz = (nM - fm) < WGM ? (nM - fm) : WGM;
        u.pm = fm + ((wgid % nig) % gsz); u.pn = (wgid % nig) / gsz; return true;
    }
    __device__ __forceinline__ void a_ready(const Unit&) const {}
    __device__ __forceinline__ void done(const Unit&) const {}
};

__device__ __forceinline__ unsigned cvt_pk_bf16(float lo, float hi) { unsigned r; asm volatile("v_cvt_pk_bf16_f32 %0, %1, %2" : "=v"(r) : "v"(lo), "v"(hi)); return r; }
template <class Epi, class Sched, bool ALIGN_EPI = false, bool SP2 = false>
__device__ __forceinline__ void gemm_phase(PG8_LAS unsigned char* lds, const Gemm g, const Sched& S, const Epi& E) {
    int tid_l = threadIdx.x; asm volatile("" : "+v"(tid_l));
    const int tid = tid_l, wid = __builtin_amdgcn_readfirstlane(tid >> 6), lane = tid & 63, wr = wid >> 2, wc = wid & 3, fr = lane & 15, fq = lane >> 4;
    const int K = g.K, nt = K / BK;
    unsigned voffA[2], voffB[2];
#pragma unroll
    for (int i = 0; i < 2; ++i) { int R, C; stage_rc(tid * 16 + i * 8192, R, C); const int Rb = Epi::PERM ? ((R & ~31) + perm32(R & 31)) : R;
        voffA[i] = (unsigned)(R * K + C) * 2u; voffB[i] = (unsigned)(Rb * K + C) * 2u; }
    const size_t kstep = (size_t)(BK * 2);
    const size_t hstep = (size_t)HALF * K * 2;
    const size_t tstep = 2 * hstep;
    const unsigned ldsw = (unsigned)wid * 1024u;
    const int aoff = lds_byte(wr * 64 + fr, fq * 8), boff = lds_byte(wc * 32 + fr, fq * 8);
#define PG8_SA(b, h) (((b) * 2 + (h)) * HTB)
#define PG8_SB(b, h) ((4 + (b) * 2 + (h)) * HTB)
#define PG8_STAGE(bufoff, gbase, voff) do { _Pragma("unroll") for (int _i = 0; _i < 2; ++_i) \
        __builtin_amdgcn_global_load_lds((const unsigned*)((const char*)(gbase) + (voff)[_i]), (PG8_LAS unsigned*)(lds + (bufoff) + ldsw + _i * 8192), 16, 0, 0); } while (0)
#define PG8_LDA(dst, b, h) do { _Pragma("unroll") for (int m = 0; m < 4; ++m) _Pragma("unroll") for (int k = 0; k < 2; ++k) dst[m][k] = *(const PG8_LAS bf16x8*)(lds + PG8_SA(b, h) + aoff + m * 2048 + k * 1024); } while (0)
#define PG8_LDB(dst, b, h) do { _Pragma("unroll") for (int n = 0; n < 2; ++n) _Pragma("unroll") for (int k = 0; k < 2; ++k) dst[n][k] = *(const PG8_LAS bf16x8*)(lds + PG8_SB(b, h) + boff + n * 2048 + k * 1024); } while (0)
#define PG8_MMA(ai, bj, At, Bt) do { __builtin_amdgcn_s_setprio(1); _Pragma("unroll") for (int m = 0; m < 4; ++m) _Pragma("unroll") for (int n = 0; n < 2; ++n) _Pragma("unroll") for (int k = 0; k < 2; ++k) \
        acc[ai][bj][m][n] = __builtin_amdgcn_mfma_f32_16x16x32_bf16(Bt[n][k], At[m][k], acc[ai][bj][m][n], 0, 0, 0); __builtin_amdgcn_s_setprio(0); } while (0)
#define PG8_WAIT_V(n) asm volatile("s_waitcnt vmcnt(" #n ")" ::: "memory")
#define PG8_WAIT_L(n) asm volatile("s_waitcnt lgkmcnt(" #n ")" ::: "memory")
#define PG8_BAR __builtin_amdgcn_s_barrier()
#define PG8_SCHED __builtin_amdgcn_sched_barrier(0)
    Unit cur, nxt; int ui = 0;
    if (!S.next(0, cur)) return;
    f32x4 acc[2][2][4][2];
#pragma unroll
    for (int a = 0; a < 2; ++a)
#pragma unroll
        for (int b = 0; b < 2; ++b)
#pragma unroll
            for (int m = 0; m < 4; ++m)
#pragma unroll
                for (int n = 0; n < 2; ++n) acc[a][b][m][n] = (f32x4){0.f, 0.f, 0.f, 0.f};
    bf16x8 At[4][2], B0[2][2], B1[2][2];
    const char* cA = (const char*)g.A + (size_t)cur.pm * tstep; const char* cB = (const char*)g.Bt + (size_t)cur.pn * tstep;
    S.a_ready(cur);
    if constexpr (SP2) {
        PG8_STAGE(PG8_SB(0, 0), cB, voffB); PG8_STAGE(PG8_SB(0, 1), cB + hstep, voffB); PG8_STAGE(PG8_SA(0, 0), cA, voffA); PG8_STAGE(PG8_SA(0, 1), cA + hstep, voffA);
        if (wr == 1) PG8_BAR;
        PG8_WAIT_V(2); PG8_BAR;
        PG8_STAGE(PG8_SB(1, 0), cB + kstep, voffB); PG8_STAGE(PG8_SA(1, 0), cA + kstep, voffA); PG8_STAGE(PG8_SB(1, 1), cB + hstep + kstep, voffB);
        PG8_WAIT_V(6); PG8_BAR;
    } else {
        PG8_STAGE(PG8_SB(0, 0), cB, voffB); PG8_STAGE(PG8_SA(0, 0), cA, voffA); PG8_STAGE(PG8_SB(0, 1), cB + hstep, voffB); PG8_STAGE(PG8_SA(0, 1), cA + hstep, voffA);
        if (wr == 1) PG8_BAR;
        PG8_WAIT_V(4); PG8_BAR;
        PG8_STAGE(PG8_SB(1, 0), cB + kstep, voffB); PG8_STAGE(PG8_SA(1, 0), cA + kstep, voffA); PG8_STAGE(PG8_SB(1, 1), cB + hstep + kstep, voffB);
        PG8_WAIT_V(6); PG8_BAR;
    }
    for (;;) {
        const bool has_next = S.next(ui + 1, nxt);
        const char* nA = has_next ? (const char*)g.A + (size_t)nxt.pm * tstep : cA; const char* nB = has_next ? (const char*)g.Bt + (size_t)nxt.pn * tstep : cB;
        for (int t = 0; t < nt; t += 2) {
            const bool last = (t == nt - 2);
            const char* a1 = cA + (size_t)(t + 1) * kstep;
            const char* a2 = last ? nA : cA + (size_t)(t + 2) * kstep; const char* b2 = last ? nB : cB + (size_t)(t + 2) * kstep;
            const char* a3 = a2 + kstep; const char* b3 = b2 + kstep;
            if (last && has_next) S.a_ready(nxt);
            if constexpr (SP2) {
            PG8_LDB(B0, 0, 0); PG8_LDB(B1, 0, 1); PG8_SCHED; PG8_LDA(At, 0, 0); PG8_STAGE(PG8_SA(1, 1), a1 + hstep, voffA);
            PG8_WAIT_V(8); PG8_WAIT_L(0); PG8_BAR; PG8_MMA(0, 0, At, B0); PG8_MMA(0, 1, At, B1); PG8_BAR; PG8_SCHED;
            PG8_LDA(At, 0, 1); PG8_STAGE(PG8_SB(0, 0), b2, voffB); PG8_STAGE(PG8_SB(0, 1), b2 + hstep, voffB); PG8_STAGE(PG8_SA(0, 0), a2, voffA);
            PG8_WAIT_V(8); PG8_WAIT_L(0); PG8_BAR; PG8_MMA(1, 0, At, B0); PG8_MMA(1, 1, At, B1); PG8_BAR; PG8_SCHED;
            PG8_LDB(B0, 1, 0); PG8_LDB(B1, 1, 1); PG8_SCHED; PG8_LDA(At, 1, 0); PG8_STAGE(PG8_SA(0, 1), a2 + hstep, voffA);
            PG8_WAIT_V(8); PG8_WAIT_L(0); PG8_BAR; PG8_MMA(0, 0, At, B0); PG8_MMA(0, 1, At, B1); PG8_BAR; PG8_SCHED;
            PG8_LDA(At, 1, 1); PG8_STAGE(PG8_SB(1, 0), b3, voffB); PG8_STAGE(PG8_SB(1, 1), b3 + hstep, voffB); PG8_STAGE(PG8_SA(1, 0), a3, voffA);
            PG8_WAIT_V(8); PG8_WAIT_L(0); PG8_BAR; PG8_MMA(1, 0, At, B0); PG8_MMA(1, 1, At, B1); PG8_BAR; PG8_SCHED;
            } else {
            PG8_LDB(B0, 0, 0); PG8_SCHED; PG8_LDA(At, 0, 0); PG8_STAGE(PG8_SA(1, 1), a1 + hstep, voffA);
            PG8_WAIT_L(8); PG8_BAR; PG8_WAIT_L(0); PG8_MMA(0, 0, At, B0); PG8_BAR; PG8_SCHED;
            PG8_LDB(B1, 0, 1); PG8_STAGE(PG8_SB(0, 0), b2, voffB);
            PG8_BAR; PG8_WAIT_L(0); PG8_MMA(0, 1, At, B1); PG8_BAR;
            PG8_LDA(At, 0, 1); PG8_STAGE(PG8_SA(0, 0), a2, voffA);
            PG8_BAR; PG8_WAIT_L(0); PG8_MMA(1, 0, At, B0); PG8_BAR; PG8_SCHED;
            PG8_STAGE(PG8_SB(0, 1), b2 + hstep, voffB);
            PG8_WAIT_V(6); PG8_BAR; PG8_MMA(1, 1, At, B1); PG8_BAR;
            PG8_LDB(B0, 1, 0); PG8_SCHED; PG8_LDA(At, 1, 0); PG8_STAGE(PG8_SA(0, 1), a2 + hstep, voffA);
            PG8_WAIT_L(8); PG8_BAR; PG8_WAIT_L(0); PG8_MMA(0, 0, At, B0); PG8_BAR; PG8_SCHED;
            PG8_LDB(B1, 1, 1); PG8_STAGE(PG8_SB(1, 0), b3, voffB);
            PG8_BAR; PG8_WAIT_L(0); PG8_MMA(0, 1, At, B1); PG8_BAR;
            PG8_LDA(At, 1, 1); PG8_STAGE(PG8_SA(1, 0), a3, voffA);
            PG8_BAR; PG8_WAIT_L(0); PG8_MMA(1, 0, At, B0); PG8_BAR; PG8_SCHED;
            PG8_STAGE(PG8_SB(1, 1), b3 + hstep, voffB);
            PG8_WAIT_V(6); PG8_BAR; PG8_MMA(1, 1, At, B1); PG8_BAR;
            }
        }
        if constexpr (ALIGN_EPI) { if (wr == 0) PG8_BAR; }
        if constexpr (!Epi::AFTER_DRAIN) { E(acc, cur, wr, wc, fr, fq); S.done(cur); }
        if (!has_next) break;
#pragma unroll
        for (int a = 0; a < 2; ++a)
#pragma unroll
            for (int b = 0; b < 2; ++b)
#pragma unroll
                for (int m = 0; m < 4; ++m)
#pragma unroll
                    for (int n = 0; n < 2; ++n) acc[a][b][m][n] = (f32x4){0.f, 0.f, 0.f, 0.f};
        cur = nxt; cA = nA; cB = nB; ++ui;
        if constexpr (ALIGN_EPI) { if (wr == 1) PG8_BAR; }
    }
    PG8_WAIT_V(0);
    if constexpr (!ALIGN_EPI) { if (wr == 0) PG8_BAR; }
    PG8_BAR;
    if constexpr (Epi::AFTER_DRAIN) { E.fused(acc, cur, wr, wc, fr, fq, lds, wid, lane); S.done(cur); }
#undef PG8_SA
#undef PG8_SB
#undef PG8_STAGE
#undef PG8_LDA
#undef PG8_LDB
#undef PG8_MMA
#undef PG8_WAIT_V
#undef PG8_WAIT_L
#undef PG8_BAR
#undef PG8_SCHED
}
}

constexpr int DM = 1024, BATCH = 2, SEQ = 8192, MTOK = BATCH * SEQ, NMEM = 256, DFF = 2816, DIN = 3104, NPROJ = 3072;
constexpr float EPS = 1e-6f;
constexpr size_t MiB = 1u << 20;
constexpr size_t WS_ROWSS = 0;
constexpr size_t WS_Z = 1 * MiB;
constexpr size_t WS_DECAY = 3 * MiB;
constexpr size_t WS_W1CAT = 4 * MiB;
constexpr size_t WS_WD1 = 19 * MiB;
constexpr size_t WS_WIN = 25 * MiB;
constexpr size_t WS_WZ = 31 * MiB;
constexpr size_t WS_WOUT = 32 * MiB, WS_WQ = 34 * MiB, WS_WO = 36 * MiB;
constexpr size_t WS_W2CAT = 38 * MiB;
constexpr size_t WS_WD2 = 49 * MiB;
constexpr size_t WS_KMEM = 55 * MiB;
constexpr size_t WS_VT = 56 * MiB;
constexpr size_t WS_MIX = 58 * MiB;
constexpr size_t WS_R = 90 * MiB;
constexpr size_t WS_XG = 186 * MiB;
constexpr size_t WS_ST = 186 * MiB;
constexpr size_t WS_END = 256 * MiB;
constexpr size_t WS_PART = 256 * 1024;
constexpr size_t WS_BAR = 768 * 1024;
constexpr int LDS_MISC = 135168;
constexpr int LDS_BYTES = LDS_MISC + 64;

#define LAS __attribute__((address_space(3)))
typedef unsigned short bf16;
typedef unsigned v4u __attribute__((ext_vector_type(4)));
typedef unsigned v2u __attribute__((ext_vector_type(2)));
typedef float f32x4 __attribute__((ext_vector_type(4)));
typedef short bf16x8 __attribute__((ext_vector_type(8)));
#define LDS_WAIT() asm volatile("s_waitcnt lgkmcnt(0)" ::: "memory")

typedef float f32x2v __attribute__((ext_vector_type(2)));
typedef __bf16 bf16x2v __attribute__((ext_vector_type(2)));
__device__ __forceinline__ unsigned pk2(float lo, float hi) { const f32x2v v = {lo, hi}; const bf16x2v b = __builtin_convertvector(v, bf16x2v); return __builtin_bit_cast(unsigned, b); }
__device__ __forceinline__ float bflo(unsigned w) { return __uint_as_float(w << 16); }
__device__ __forceinline__ float bfhi(unsigned w) { return __uint_as_float(w & 0xffff0000u); }
__device__ __forceinline__ float silu_f(float x) { return x * __builtin_amdgcn_rcpf(1.f + __expf(-x)); }
__device__ __forceinline__ float logsig_f(float a) { return fminf(a, 0.f) - __logf(1.f + __expf(-fabsf(a))); }
__device__ __forceinline__ float wave_sum(float v) {
#pragma unroll
    for (int o = 1; o < 64; o <<= 1) v += __shfl_xor(v, o);
    return v;
}
__device__ __forceinline__ bf16x8 mk8(unsigned a, unsigned b, unsigned c, unsigned d) { v4u w = {a, b, c, d}; return __builtin_bit_cast(bf16x8, w); }
#define MFMA16(a, b, c) __builtin_amdgcn_mfma_f32_16x16x32_bf16((a), (b), (c), 0, 0, 0)

struct EpiUp {
    static constexpr bool PERM = true, AFTER_DRAIN = false;
    bf16* act; const float* rowss; bf16* Kmem; bf16* VT; int npn_main;
    __device__ __forceinline__ void operator()(const pg8::f32x4 (&acc)[2][2][4][2], const pg8::Unit& u, int wr, int wc, int fr, int fq) const {
        if (u.pn < npn_main) {
            const int row0 = u.pm * 256 + wr * 64 + fr, col0 = u.pn * 128 + wc * 32 + 8 * fq;
            float rsv[2][4];
#pragma unroll
            for (int ai = 0; ai < 2; ++ai)
#pragma unroll
                for (int m = 0; m < 4; ++m) rsv[ai][m] = rowss ? rowss[row0 + ai * 128 + m * 16] : 0.f;
#pragma unroll
            for (int ai = 0; ai < 2; ++ai)
#pragma unroll
                for (int m = 0; m < 4; ++m) {
                    const int r = row0 + ai * 128 + m * 16;
                    const float rs = rowss ? rsqrtf(rsv[ai][m] * (1.f / DM) + EPS) : 1.f;
                    float o[8];
#pragma unroll
                    for (int n = 0; n < 2; ++n)
#pragma unroll
                        for (int i = 0; i < 4; ++i) { const float g = acc[ai][0][m][n][i] * rs, uu = acc[ai][1][m][n][i] * rs; o[n * 4 + i] = silu_f(g) * uu; }
                    v4u w = {pk2(o[0], o[1]), pk2(o[2], o[3]), pk2(o[4], o[5]), pk2(o[6], o[7])};
                    *(v4u*)(act + (size_t)r * DFF + col0) = w;
                }
        } else {
            const int hsel = u.pn - npn_main;
            const int mt0 = (u.pm - MTOK / 256) * 256 + wr * 64 + fr;
#pragma unroll
            for (int ai = 0; ai < 2; ++ai)
#pragma unroll
                for (int m = 0; m < 4; ++m) {
                    const int mt = mt0 + ai * 128 + m * 16, b = mt >> 8, key = mt & 255;
#pragma unroll
                    for (int bj = 0; bj < 2; ++bj) {
                        const int d0 = bj * 128 + wc * 32 + 8 * fq;
                        const f32x4 v0 = acc[ai][bj][m][0], v1 = acc[ai][bj][m][1];
                        if (hsel < 4) {
                            v4u w = {pk2(v0[0], v0[1]), pk2(v0[2], v0[3]), pk2(v1[0], v1[1]), pk2(v1[2], v1[3])};
                            *(v4u*)(Kmem + ((size_t)((b * 4 + hsel) * 256 + key)) * 256 + d0) = w;
                        } else {
                            bf16* dst = VT + ((size_t)((b * 4 + hsel - 4) * 256 + d0)) * 256 + key;
                            const unsigned w0 = pk2(v0[0], v0[1]), w1 = pk2(v0[2], v0[3]), w2 = pk2(v1[0], v1[1]), w3 = pk2(v1[2], v1[3]);
                            dst[0 * 256] = (bf16)(w0 & 0xffffu); dst[1 * 256] = (bf16)(w0 >> 16); dst[2 * 256] = (bf16)(w1 & 0xffffu); dst[3 * 256] = (bf16)(w1 >> 16);
                            dst[4 * 256] = (bf16)(w2 & 0xffffu); dst[5 * 256] = (bf16)(w2 >> 16); dst[6 * 256] = (bf16)(w3 & 0xffffu); dst[7 * 256] = (bf16)(w3 >> 16);
                        }
                    }
                }
        }
    }
};
struct EpiResF {
    static constexpr bool PERM = false, AFTER_DRAIN = false;
    const bf16* base; float* out; float alpha;
    __device__ __forceinline__ void operator()(const pg8::f32x4 (&acc)[2][2][4][2], const pg8::Unit& u, int wr, int wc, int fr, int fq) const {
        const int row0 = u.pm * 256 + wr * 64 + fr, col0 = u.pn * 256 + wc * 32 + 4 * fq;
#pragma unroll
        for (int ai = 0; ai < 2; ++ai)
#pragma unroll
            for (int m = 0; m < 4; ++m) {
                const size_t off = (size_t)(row0 + ai * 128 + m * 16) * DM + col0;
#pragma unroll
                for (int bj = 0; bj < 2; ++bj)
#pragma unroll
                    for (int n = 0; n < 2; ++n) {
                        const v2u bw = *(const v2u*)(base + off + bj * 128 + n * 16);
                        const f32x4 bs = {bflo(bw.x), bfhi(bw.x), bflo(bw.y), bfhi(bw.y)};
                        *(f32x4*)(out + off + bj * 128 + n * 16) = bs + acc[ai][bj][m][n] * alpha;
                    }
            }
    }
};
struct EpiResB {
    static constexpr bool PERM = true, AFTER_DRAIN = false;
    const float* basef; bf16* xs; float* rowss; float alpha;
    __device__ __forceinline__ void operator()(const pg8::f32x4 (&acc)[2][2][4][2], const pg8::Unit& u, int wr, int wc, int fr, int fq) const {
        const int row0 = u.pm * 256 + wr * 64 + fr, col0 = u.pn * 256 + wc * 32 + 8 * fq;
#pragma unroll
        for (int ai = 0; ai < 2; ++ai) {
            f32x4 b0[4][2], b1[4][2];
            if (basef) {
#pragma unroll
                for (int m = 0; m < 4; ++m)
#pragma unroll
                    for (int bj = 0; bj < 2; ++bj) { const float* bp = basef + (size_t)(row0 + ai * 128 + m * 16) * DM + col0 + bj * 128; b0[m][bj] = __builtin_nontemporal_load((const f32x4*)bp); b1[m][bj] = __builtin_nontemporal_load((const f32x4*)(bp + 4));     }
            } else {
                v4u bw[4][2];
#pragma unroll
                for (int m = 0; m < 4; ++m)
#pragma unroll
                    for (int bj = 0; bj < 2; ++bj) bw[m][bj] = *(const v4u*)(xs + (size_t)(row0 + ai * 128 + m * 16) * DM + col0 + bj * 128);
#pragma unroll
                for (int m = 0; m < 4; ++m)
#pragma unroll
                    for (int bj = 0; bj < 2; ++bj) { const v4u w = bw[m][bj]; b0[m][bj] = (f32x4){bflo(w.x), bfhi(w.x), bflo(w.y), bfhi(w.y)}; b1[m][bj] = (f32x4){bflo(w.z), bfhi(w.z), bflo(w.w), bfhi(w.w)}; }
            }
#pragma unroll
            for (int m = 0; m < 4; ++m) {
                const int r = row0 + ai * 128 + m * 16; const size_t off = (size_t)r * DM + col0; float ss = 0.f;
#pragma unroll
                for (int bj = 0; bj < 2; ++bj) {
                    const f32x4 v0 = b0[m][bj] + acc[ai][bj][m][0] * alpha, v1 = b1[m][bj] + acc[ai][bj][m][1] * alpha;
                    ss += ((v0[0] * v0[0] + v0[1] * v0[1]) + (v0[2] * v0[2] + v0[3] * v0[3])) + ((v1[0] * v1[0] + v1[1] * v1[1]) + (v1[2] * v1[2] + v1[3] * v1[3]));
                    *(v4u*)(xs + off + bj * 128) = (v4u){pk2(v0[0], v0[1]), pk2(v0[2], v0[3]), pk2(v1[0], v1[1]), pk2(v1[2], v1[3])};
                }
                ss += __shfl_xor(ss, 16); ss += __shfl_xor(ss, 32); if (fq == 0) atomicAdd(rowss + r, ss);
            }
        }
    }
};
struct EpiScale {
    static constexpr bool PERM = true, AFTER_DRAIN = false;
    bf16* O; int ldc; const float* rowss; float scale; bool nt;
    __device__ __forceinline__ void operator()(const pg8::f32x4 (&acc)[2][2][4][2], const pg8::Unit& u, int wr, int wc, int fr, int fq) const {
        const int row0 = u.pm * 256 + wr * 64 + fr, col0 = u.pn * 256 + wc * 32 + 8 * fq;
        float rsv[2][4];
#pragma unroll
        for (int ai = 0; ai < 2; ++ai)
#pragma unroll
            for (int m = 0; m < 4; ++m) rsv[ai][m] = rowss[row0 + ai * 128 + m * 16];
#pragma unroll
        for (int ai = 0; ai < 2; ++ai)
#pragma unroll
            for (int m = 0; m < 4; ++m) {
                const int r = row0 + ai * 128 + m * 16;
                const float rs = rsqrtf(rsv[ai][m] * (1.f / DM) + EPS) * scale;
#pragma unroll
                for (int bj = 0; bj < 2; ++bj) {
                    const f32x4 v0 = acc[ai][bj][m][0] * rs, v1 = acc[ai][bj][m][1] * rs;
                    v4u w = {pk2(v0[0], v0[1]), pk2(v0[2], v0[3]), pk2(v1[0], v1[1]), pk2(v1[2], v1[3])};
                    if (nt) __builtin_nontemporal_store(w, (v4u*)(O + (size_t)r * ldc + col0 + bj * 128)); else *(v4u*)(O + (size_t)r * ldc + col0 + bj * 128) = w;
                }
            }
    }
};
struct EpiResNorm {
    static constexpr bool PERM = false, AFTER_DRAIN = true;
    const bf16* base; float* out; const float* gain; float alpha; float* part; unsigned* cnt;
    __device__ __forceinline__ void fused(pg8::f32x4 (&acc)[2][2][4][2], const pg8::Unit& u, int wr, int wc, int fr, int fq, PG8_LAS unsigned char* lds, int wid, int lane) const {
        const int row0 = u.pm * 256 + wr * 64 + fr, col0 = u.pn * 256 + wc * 32 + 4 * fq;
        LAS float* P = (LAS float*)lds;
        LAS float* S = (LAS float*)(lds + 4096);
#pragma unroll
        for (int ai = 0; ai < 2; ++ai) {
            v2u bw[4][2][2];
#pragma unroll
            for (int m = 0; m < 4; ++m)
#pragma unroll
                for (int bj = 0; bj < 2; ++bj)
#pragma unroll
                    for (int n = 0; n < 2; ++n) bw[m][bj][n] = *(const v2u*)(base + (size_t)(row0 + ai * 128 + m * 16) * DM + col0 + bj * 128 + n * 16);
#pragma unroll
            for (int m = 0; m < 4; ++m) {
                float ss = 0.f;
#pragma unroll
                for (int bj = 0; bj < 2; ++bj)
#pragma unroll
                    for (int n = 0; n < 2; ++n) {
                        const v2u w = bw[m][bj][n];
                        const f32x4 bs = {bflo(w.x), bfhi(w.x), bflo(w.y), bfhi(w.y)};
                        const f32x4 v = bs + acc[ai][bj][m][n] * alpha;
                        acc[ai][bj][m][n] = v;
                        ss += (v[0] * v[0] + v[1] * v[1]) + (v[2] * v[2] + v[3] * v[3]);
                    }
                ss += __shfl_xor(ss, 16); ss += __shfl_xor(ss, 32);
                if (fq == 0) P[(ai * 128 + wr * 64 + m * 16 + fr) * 4 + wc] = ss;
            }
        }
        __syncthreads();
        const int tid = wid * 64 + lane;
        if (tid < 256) {
            const float t = (P[tid * 4] + P[tid * 4 + 1]) + (P[tid * 4 + 2] + P[tid * 4 + 3]);
            __hip_atomic_store(part + (size_t)(u.pm * 256 + tid) * 4 + u.pn, t, __ATOMIC_RELAXED, __HIP_MEMORY_SCOPE_AGENT);
        }
        asm volatile("s_waitcnt vmcnt(0)" ::: "memory");
        __syncthreads();
        if (tid == 0) {
            __hip_atomic_fetch_add(cnt + 64 * u.pm, 1u, __ATOMIC_RELEASE, __HIP_MEMORY_SCOPE_AGENT);
            unsigned sp = 0;
            while (__hip_atomic_load(cnt + 64 * u.pm, __ATOMIC_RELAXED, __HIP_MEMORY_SCOPE_AGENT) < 4u && ++sp < (1u << 22)) __builtin_amdgcn_s_sleep(2);
            __builtin_amdgcn_fence(__ATOMIC_ACQUIRE, "agent");
        }
        __syncthreads();
        if (tid < 256) {
            const float* pp = part + (size_t)(u.pm * 256 + tid) * 4;
            const float t = (__hip_atomic_load(pp, __ATOMIC_RELAXED, __HIP_MEMORY_SCOPE_AGENT) + __hip_atomic_load(pp + 1, __ATOMIC_RELAXED, __HIP_MEMORY_SCOPE_AGENT))
                          + (__hip_atomic_load(pp + 2, __ATOMIC_RELAXED, __HIP_MEMORY_SCOPE_AGENT) + __hip_atomic_load(pp + 3, __ATOMIC_RELAXED, __HIP_MEMORY_SCOPE_AGENT));
            S[tid] = rsqrtf(t * (1.f / DM) + EPS);
        }
        __syncthreads();
        f32x4 gv[2][2];
#pragma unroll
        for (int bj = 0; bj < 2; ++bj)
#pragma unroll
            for (int n = 0; n < 2; ++n) gv[bj][n] = *(const f32x4*)(gain + col0 + bj * 128 + n * 16);
#pragma unroll
        for (int ai = 0; ai < 2; ++ai)
#pragma unroll
            for (int m = 0; m < 4; ++m) {
                const int rl = ai * 128 + wr * 64 + m * 16 + fr; const float rs = S[rl]; const size_t off = (size_t)(u.pm * 256 + rl) * DM + col0;
#pragma unroll
                for (int bj = 0; bj < 2; ++bj)
#pragma unroll
                    for (int n = 0; n < 2; ++n) { f32x4 ov = acc[ai][bj][m][n] * rs * gv[bj][n];
                        *(f32x4*)(out + off + bj * 128 + n * 16) = ov; }
            }
    }
};
struct OrderUpKV {
    pg8::StaticOrder base; int extra;
    __device__ bool next(int i, pg8::Unit& u) const {
        long L = (long)i * base.G + base.c;
        if (L < base.nwg) return base.next(i, u);
        L -= base.nwg; if (L >= extra) return false;
        u.pm = MTOK / 256 + (int)(L / 8); u.pn = base.nN + (int)(L % 8); return true;
    }
    __device__ __forceinline__ void a_ready(const pg8::Unit&) const {}
    __device__ __forceinline__ void done(const pg8::Unit&) const {}
};

template <int NW>
__device__ __forceinline__ void tr_tile(const float* __restrict__ W, int N, int K, int k0, int n0, bf16* orow0, LAS float* scr, int lane, const float* gain = nullptr) {
    constexpr int LPR = NW / 4, RPI = 64 / LPR, NI = 64 / RPI, STR = NW + 1, NO = NW * 8 / 64;
    const int kr = lane / LPR, nc = (lane % LPR) * 4;
    f32x4 v[NI];
#pragma unroll
    for (int i = 0; i < NI; ++i) v[i] = __builtin_nontemporal_load((const f32x4*)(W + (size_t)(k0 + i * RPI + kr) * N + n0 + nc));
    if (gain) {
#pragma unroll
        for (int i = 0; i < NI; ++i) v[i] = v[i] * gain[k0 + i * RPI + kr];
    }
#pragma unroll
    for (int i = 0; i < NI; ++i) { LAS float* d = scr + (i * RPI + kr) * STR + nc; d[0] = v[i][0]; d[1] = v[i][1]; d[2] = v[i][2]; d[3] = v[i][3]; }
    LDS_WAIT();
#pragma unroll
    for (int j = 0; j < NO; ++j) {
        const int idx = j * 64 + lane, c = idx & 7, n = idx >> 3; const LAS float* sp = scr + (8 * c) * STR + n;
        v4u o; o.x = pk2(sp[0 * STR], sp[1 * STR]); o.y = pk2(sp[2 * STR], sp[3 * STR]); o.z = pk2(sp[4 * STR], sp[5 * STR]); o.w = pk2(sp[6 * STR], sp[7 * STR]);
        *(v4u*)(orow0 + (size_t)n * K + k0 + 8 * c) = o;
    }
    LDS_WAIT();
}
__device__ __forceinline__ void norm_rows2_bf16(const float* x0, const float* x1, const float* gain, bf16* o0, bf16* o1, int lane) {
    const f32x4* xr0 = (const f32x4*)x0 + lane; const f32x4* xr1 = (const f32x4*)x1 + lane; const f32x4* gr = (const f32x4*)gain + lane;
    f32x4 v0[4], v1[4]; float s0 = 0.f, s1 = 0.f;
#pragma unroll
    for (int j = 0; j < 4; ++j) { v0[j] = __builtin_nontemporal_load(xr0 + 64 * j); v1[j] = __builtin_nontemporal_load(xr1 + 64 * j); }
#pragma unroll
    for (int j = 0; j < 4; ++j) { s0 += (v0[j][0] * v0[j][0] + v0[j][1] * v0[j][1]) + (v0[j][2] * v0[j][2] + v0[j][3] * v0[j][3]); s1 += (v1[j][0] * v1[j][0] + v1[j][1] * v1[j][1]) + (v1[j][2] * v1[j][2] + v1[j][3] * v1[j][3]); }
    const float r0 = rsqrtf(wave_sum(s0) * (1.f / DM) + EPS), r1 = rsqrtf(wave_sum(s1) * (1.f / DM) + EPS);
    v2u* p0 = (v2u*)o0 + lane; v2u* p1 = (v2u*)o1 + lane;
#pragma unroll
    for (int j = 0; j < 4; ++j) { const f32x4 gg = gr[64 * j]; const f32x4 t0 = v0[j] * r0 * gg, t1 = v1[j] * r1 * gg;
        p0[64 * j] = (v2u){pk2(t0[0], t0[1]), pk2(t0[2], t0[3])}; p1[64 * j] = (v2u){pk2(t1[0], t1[1]), pk2(t1[2], t1[3])}; }
}

constexpr int GL_STR = 72;
constexpr int GL_A0 = 0, GL_A1 = 9216, GL_A2 = 18432, GL_A3 = 27648, GL_VT = 36864, GL_SS = 36864 + 18432;

struct GlaIn { unsigned short qr[4][4], kr[4][4]; float bw[4]; float bias; f32x4 zv[4]; v4u vraw[2]; };
__device__ __forceinline__ void gla_front_load(GlaIn& R, const float* z, const bf16* proj, const float* gfw, const float* gfb, const float* gbw, const float* gbb,
                                               int b, int h, int n, int tid, int wave, int lane) {
    const int fr = lane & 15, fq = lane >> 4, jt = wave & 3, dir = wave >> 2;
    const int T0 = b * SEQ + n * 64, col = h * 64 + jt * 16 + fr;
    const float* gw = dir ? gbw : gfw; const float* gbias = dir ? gbb : gfb;
#pragma unroll
    for (int tt = 0; tt < 4; ++tt)
#pragma unroll
        for (int i = 0; i < 4; ++i) { const bf16* pr = proj + (size_t)(T0 + tt * 16 + fq * 4 + i) * NPROJ + col; R.qr[tt][i] = pr[0]; R.kr[tt][i] = pr[256]; }
#pragma unroll
    for (int ks = 0; ks < 4; ++ks) R.bw[ks] = gw[(fq * 4 + ks) * 256 + col];
    R.bias = gbias[col];
#pragma unroll
    for (int tt = 0; tt < 4; ++tt) R.zv[tt] = *(const f32x4*)(z + (size_t)(T0 + tt * 16 + fr) * 32 + dir * 16 + fq * 4);
#pragma unroll
    for (int i = 0; i < 2; ++i) { const int cc = tid + 512 * i; R.vraw[i] = *(const v4u*)(proj + (size_t)(T0 + (cc & 63)) * NPROJ + 512 + h * 128 + (cc >> 6) * 8); }
}
template <bool G1>
__device__ __forceinline__ void gla_front_compute(const GlaIn& R, LAS unsigned char* lds, float* decay, int b, int h, int n, int tid, int wave, int lane) {
    const int fr = lane & 15, fq = lane >> 4, jt = wave & 3, dir = wave >> 2, bh = b * 4 + h;
    float g[4][4], c[4][4];
#pragma unroll
    for (int tt = 0; tt < 4; ++tt) {
        f32x4 a = {R.bias, R.bias, R.bias, R.bias};
#pragma unroll
        for (int ks = 0; ks < 4; ++ks) a = __builtin_amdgcn_mfma_f32_16x16x4f32(R.zv[tt][ks], R.bw[ks], a, 0, 0, 0);
#pragma unroll
        for (int i = 0; i < 4; ++i) g[tt][i] = logsig_f(a[i]) * (1.f / 16.f);
    }
    float base = 0.f;
#pragma unroll
    for (int tt = 0; tt < 4; ++tt) {
        const float p0 = g[tt][0], p1 = p0 + g[tt][1], p2 = p1 + g[tt][2], p3 = p2 + g[tt][3];
        const float x1 = __shfl_up(p3, 16), x2 = __shfl_up(p3, 32), x3 = __shfl_up(p3, 48);
        const float excl = (fq >= 1 ? x1 : 0.f) + (fq >= 2 ? x2 : 0.f) + (fq >= 3 ? x3 : 0.f);
        const float ttot = __shfl(excl + p3, 48 + fr);
        const float off = base + excl;
        c[tt][0] = off + p0; c[tt][1] = off + p1; c[tt][2] = off + p2; c[tt][3] = off + p3;
        base += ttot;
    }
    const float total = base;
    if (dir) {
#pragma unroll
        for (int tt = 0; tt < 4; ++tt)
#pragma unroll
            for (int i = 0; i < 4; ++i) c[tt][i] = total - c[tt][i] + g[tt][i];
    }
    if (G1) {
        LAS bf16* KS = (LAS bf16*)(lds + (dir ? GL_A1 : GL_A0));
#pragma unroll
        for (int tt = 0; tt < 4; ++tt) {
            float e[4];
#pragma unroll
            for (int i = 0; i < 4; ++i) e[i] = __uint_as_float((unsigned)R.kr[tt][i] << 16) * __expf(total - c[tt][i]);
            *(LAS v2u*)(KS + (jt * 16 + fr) * GL_STR + tt * 16 + fq * 4) = (v2u){pk2(e[0], e[1]), pk2(e[2], e[3])};
        }
        if (fq == 0) decay[((size_t)(dir * 8 + bh) * 128 + n) * 64 + jt * 16 + fr] = __expf(total);
    } else {
        LAS bf16* Qd = (LAS bf16*)(lds + (dir ? GL_A2 : GL_A0)); LAS bf16* Kd = (LAS bf16*)(lds + (dir ? GL_A3 : GL_A1));
#pragma unroll
        for (int tt = 0; tt < 4; ++tt)
#pragma unroll
            for (int i = 0; i < 4; ++i) {
                const int t = tt * 16 + fq * 4 + i;
                const float q = __uint_as_float((unsigned)R.qr[tt][i] << 16) * 0.125f, k = __uint_as_float((unsigned)R.kr[tt][i] << 16);
                const unsigned w = pk2(q * __expf(c[tt][i]), k * __expf(-c[tt][i]));
                Qd[t * GL_STR + jt * 16 + fr] = (bf16)(w & 0xffffu); Kd[t * GL_STR + jt * 16 + fr] = (bf16)(w >> 16);
            }
    }
    LAS bf16* VTl = (LAS bf16*)(lds + GL_VT);
#pragma unroll
    for (int j = 0; j < 2; ++j) {
        const int cc = tid + 512 * j, t = cc & 63, dvc = cc >> 6;
        const v4u raw = R.vraw[j];
        LAS bf16* dst = VTl + (dvc * 8) * GL_STR + t;
#pragma unroll
        for (int i = 0; i < 8; ++i) dst[i * GL_STR] = (bf16)((i & 1) ? (raw[i >> 1] >> 16) : (raw[i >> 1] & 0xffffu));
    }
}

__device__ __forceinline__ void gla_g1(LAS unsigned char* lds, const float* z, const bf16* proj, const float* gfw, const float* gfb, const float* gbw, const float* gbb,
                                       float* decay, bf16* ST, const float* conv_w, const float* conv_b, bf16* mix, int G, int bid, int tid, int wave, int lane) {
    const int fr = lane & 15, fq = lane >> 4;
    GlaIn R;
    if (bid < 1024) gla_front_load(R, z, proj, gfw, gfb, gbw, gbb, (bid >> 7) >> 2, (bid >> 7) & 3, bid & 127, tid, wave, lane);
    for (int it = bid; it < 1024; it += G) {
        const int bh = it >> 7, n = it & 127, b = bh >> 2, h = bh & 3;
        const int cc0 = h * 128 + (tid & 15) * 8;
        v4u cbg[2], ccg[2][3], cxv[2][3];
#pragma unroll
        for (int i = 0; i < 2; ++i) {
            const int t = b * SEQ + n * 64 + (tid >> 4) + 32 * i;
            const bf16* row = proj + (size_t)t * NPROJ;
            cbg[i] = *(const v4u*)(row + 1536 + cc0); ccg[i][1] = *(const v4u*)(row + 2048 + cc0); cxv[i][1] = *(const v4u*)(row + 2560 + cc0);
            const bool hp = (t & (SEQ - 1)) != 0, hn = (t & (SEQ - 1)) != SEQ - 1;
            ccg[i][0] = (v4u){0, 0, 0, 0}; cxv[i][0] = (v4u){0, 0, 0, 0}; ccg[i][2] = (v4u){0, 0, 0, 0}; cxv[i][2] = (v4u){0, 0, 0, 0};
            if (hp) { ccg[i][0] = *(const v4u*)(row - NPROJ + 2048 + cc0); cxv[i][0] = *(const v4u*)(row - NPROJ + 2560 + cc0); }
            if (hn) { ccg[i][2] = *(const v4u*)(row + NPROJ + 2048 + cc0); cxv[i][2] = *(const v4u*)(row + NPROJ + 2560 + cc0); }
        }
        gla_front_compute<true>(R, lds, decay, b, h, n, tid, wave, lane);
        { const int nx = it + G; if (nx < 1024) gla_front_load(R, z, proj, gfw, gfb, gbw, gbb, (nx >> 7) >> 2, (nx >> 7) & 3, nx & 127, tid, wave, lane); }
        {
            f32x4 w0[2], w1[2], w2[2], cb[2];
#pragma unroll
            for (int q = 0; q < 2; ++q) { w0[q] = *(const f32x4*)(conv_w + cc0 + 4 * q); w1[q] = *(const f32x4*)(conv_w + 512 + cc0 + 4 * q); w2[q] = *(const f32x4*)(conv_w + 1024 + cc0 + 4 * q); cb[q] = *(const f32x4*)(conv_b + cc0 + 4 * q); }
#pragma unroll
            for (int i = 0; i < 2; ++i) {
                const int t = b * SEQ + n * 64 + (tid >> 4) + 32 * i;
                float o[8];
#pragma unroll
                for (int e = 0; e < 8; ++e) {
                    const int w = e >> 1; const bool hi = e & 1;
                    const float up = (hi ? bfhi(ccg[i][0][w]) : bflo(ccg[i][0][w])) * (hi ? bfhi(cxv[i][0][w]) : bflo(cxv[i][0][w]));
                    const float uc = (hi ? bfhi(ccg[i][1][w]) : bflo(ccg[i][1][w])) * (hi ? bfhi(cxv[i][1][w]) : bflo(cxv[i][1][w]));
                    const float un = (hi ? bfhi(ccg[i][2][w]) : bflo(ccg[i][2][w])) * (hi ? bfhi(cxv[i][2][w]) : bflo(cxv[i][2][w]));
                    const float g = hi ? bfhi(cbg[i][w]) : bflo(cbg[i][w]);
                    o[e] = g * (w0[e >> 2][e & 3] * up + w1[e >> 2][e & 3] * uc + w2[e >> 2][e & 3] * un + cb[e >> 2][e & 3]);
                }
                *(v4u*)(mix + (size_t)t * DM + 512 + cc0) = (v4u){pk2(o[0], o[1]), pk2(o[2], o[3]), pk2(o[4], o[5]), pk2(o[6], o[7])};
            }
        }
        __syncthreads();
        const LAS bf16* VTl = (const LAS bf16*)(lds + GL_VT);
        bf16x8 vb[2];
#pragma unroll
        for (int ks = 0; ks < 2; ++ks) vb[ks] = *(const LAS bf16x8*)(VTl + (wave * 16 + fr) * GL_STR + ks * 32 + fq * 8);
#pragma unroll
        for (int dir = 0; dir < 2; ++dir) {
            const LAS bf16* KS = (const LAS bf16*)(lds + (dir ? GL_A1 : GL_A0));
#pragma unroll
            for (int nt = 0; nt < 4; ++nt) {
                f32x4 acc = {0.f, 0.f, 0.f, 0.f};
#pragma unroll
                for (int ks = 0; ks < 2; ++ks) { const bf16x8 ka = *(const LAS bf16x8*)(KS + (nt * 16 + fr) * GL_STR + ks * 32 + fq * 8); acc = MFMA16(ka, vb[ks], acc); }
                *(v2u*)(ST + ((size_t)(dir * 8 + bh) * 128 + n) * 8192 + (wave * 16 + fr) * 64 + nt * 16 + fq * 4) = (v2u){pk2(acc[0], acc[1]), pk2(acc[2], acc[3])};
            }
        }
        __syncthreads();
    }
}

__device__ __forceinline__ void gla_g2(bf16* ST, const float* decay, int G, int bid, int tid) {
    for (int e = bid * 512 + tid; e < 16 * 8192; e += G * 512) {
        const int chain = e >> 13, el = e & 8191, j = el & 63, dir = chain >> 3;
        bf16* base = ST + (size_t)chain * 128 * 8192 + el; const float* dec = decay + (size_t)chain * 128 * 64 + j;
        float S = 0.f;
        for (int s0 = 0; s0 < 128; s0 += 64) {
            float tmp[64], d[64];
#pragma unroll
            for (int u = 0; u < 64; ++u) { const int n = dir ? 127 - (s0 + u) : s0 + u; tmp[u] = __uint_as_float((unsigned)base[(size_t)n * 8192] << 16); d[u] = dec[n * 64]; }
#pragma unroll
            for (int u = 0; u < 64; ++u) { const int n = dir ? 127 - (s0 + u) : s0 + u; base[(size_t)n * 8192] = (bf16)(pk2(S, 0.f) & 0xffffu); S = d[u] * S + tmp[u]; }
        }
    }
}

__device__ __forceinline__ void gla_g3(LAS unsigned char* lds, const float* z, const bf16* proj, const float* gfw, const float* gfb, const float* gbw, const float* gbb,
                                       const bf16* ST, const float* gla_norm, bf16* mix, int G, int bid, int tid, int wave, int lane) {
    const int fr = lane & 15, fq = lane >> 4, tt = wave & 3, dh = wave >> 2;
    GlaIn R;
    if (bid < 1024) gla_front_load(R, z, proj, gfw, gfb, gbw, gbb, (bid >> 7) >> 2, (bid >> 7) & 3, bid & 127, tid, wave, lane);
    for (int it = bid; it < 1024; it += G) {
        const int bh = it >> 7, n = it & 127, b = bh >> 2, h = bh & 3;
        bf16x8 stf[2][4][2]; v2u rr4[4];
#pragma unroll
        for (int dir = 0; dir < 2; ++dir)
#pragma unroll
            for (int dt = 0; dt < 4; ++dt)
#pragma unroll
                for (int ks = 0; ks < 2; ++ks) stf[dir][dt][ks] = *(const bf16x8*)(ST + ((size_t)(dir * 8 + bh) * 128 + n) * 8192 + (size_t)((dh * 4 + dt) * 16 + fr) * 64 + ks * 32 + fq * 8);
#pragma unroll
        for (int dt = 0; dt < 4; ++dt) rr4[dt] = *(const v2u*)(proj + (size_t)(b * SEQ + n * 64 + tt * 16 + fr) * NPROJ + 1024 + h * 128 + (dh * 4 + dt) * 16 + fq * 4);
        gla_front_compute<false>(R, lds, nullptr, b, h, n, tid, wave, lane);
        __syncthreads();
        { const int nx = it + G; if (nx < 1024) gla_front_load(R, z, proj, gfw, gfb, gbw, gbb, (nx >> 7) >> 2, (nx >> 7) & 3, nx & 127, tid, wave, lane); }
        const LAS bf16* VTl = (const LAS bf16*)(lds + GL_VT);
        f32x4 o[4];
#pragma unroll
        for (int dt = 0; dt < 4; ++dt) o[dt] = (f32x4){0.f, 0.f, 0.f, 0.f};
#pragma unroll
        for (int dir = 0; dir < 2; ++dir) {
            const LAS bf16* Qd = (const LAS bf16*)(lds + (dir ? GL_A2 : GL_A0));
            const LAS bf16* Kd = (const LAS bf16*)(lds + (dir ? GL_A3 : GL_A1));
            bf16x8 qfr[2];
#pragma unroll
            for (int ks = 0; ks < 2; ++ks) qfr[ks] = *(const LAS bf16x8*)(Qd + (tt * 16 + fr) * GL_STR + ks * 32 + fq * 8);
            f32x4 at[4];
#pragma unroll
            for (int mt = 0; mt < 4; ++mt) {
                f32x4 a = {0.f, 0.f, 0.f, 0.f};
                const bool live = dir ? (mt >= tt) : (mt <= tt);
                if (live) {
#pragma unroll
                    for (int ks = 0; ks < 2; ++ks) { const bf16x8 kfr = *(const LAS bf16x8*)(Kd + (mt * 16 + fr) * GL_STR + ks * 32 + fq * 8); a = MFMA16(kfr, qfr[ks], a); }
                    if (mt == tt) {
#pragma unroll
                        for (int i = 0; i < 4; ++i) { const int m = fq * 4 + i; const bool keep = dir ? (m >= fr) : (m <= fr); a[i] = keep ? a[i] : 0.f; }
                    }
                }
                at[mt] = a;
            }
            bf16x8 pa[2];
#pragma unroll
            for (int s2 = 0; s2 < 2; ++s2) pa[s2] = mk8(pk2(at[2 * s2][0], at[2 * s2][1]), pk2(at[2 * s2][2], at[2 * s2][3]), pk2(at[2 * s2 + 1][0], at[2 * s2 + 1][1]), pk2(at[2 * s2 + 1][2], at[2 * s2 + 1][3]));
#pragma unroll
            for (int dt = 0; dt < 4; ++dt) {
                const int dvrow = (dh * 4 + dt) * 16 + fr;
#pragma unroll
                for (int s2 = 0; s2 < 2; ++s2) {
                    const v2u lo = *(const LAS v2u*)(VTl + dvrow * GL_STR + s2 * 32 + fq * 4), hi = *(const LAS v2u*)(VTl + dvrow * GL_STR + s2 * 32 + 16 + fq * 4);
                    o[dt] = MFMA16(mk8(lo.x, lo.y, hi.x, hi.y), pa[s2], o[dt]);
                }
#pragma unroll
                for (int ks = 0; ks < 2; ++ks) {
                    o[dt] = MFMA16(stf[dir][dt][ks], qfr[ks], o[dt]);
                }
            }
        }
        float ss = 0.f;
#pragma unroll
        for (int dt = 0; dt < 4; ++dt) ss += (o[dt][0] * o[dt][0] + o[dt][1] * o[dt][1]) + (o[dt][2] * o[dt][2] + o[dt][3] * o[dt][3]);
        ss += __shfl_xor(ss, 16); ss += __shfl_xor(ss, 32);
        LAS float* SS = (LAS float*)(lds + GL_SS);
        if (fq == 0) SS[dh * 64 + tt * 16 + fr] = ss;
        __syncthreads();
        const float tot = SS[tt * 16 + fr] + SS[64 + tt * 16 + fr];
        const float rs = rsqrtf(tot * (1.f / 128.f) + EPS);
        const int tok = b * SEQ + n * 64 + tt * 16 + fr;
#pragma unroll
        for (int dt = 0; dt < 4; ++dt) {
            const int c = h * 128 + (dh * 4 + dt) * 16 + fq * 4;
            const v2u rr = rr4[dt];
            const f32x4 gn = *(const f32x4*)(gla_norm + c);
            const float v0 = o[dt][0] * rs * gn[0] * silu_f(bflo(rr.x)), v1 = o[dt][1] * rs * gn[1] * silu_f(bfhi(rr.x));
            const float v2 = o[dt][2] * rs * gn[2] * silu_f(bflo(rr.y)), v3 = o[dt][3] * rs * gn[3] * silu_f(bfhi(rr.y));
            *(v2u*)(mix + (size_t)tok * DM + c) = (v2u){pk2(v0, v1), pk2(v2, v3)};
        }
    }
}

typedef float f32x16 __attribute__((ext_vector_type(16)));
#define MFMA32(a, b, c) __builtin_amdgcn_mfma_f32_32x32x16_bf16((a), (b), (c), 0, 0, 0)
template <int RS>
__device__ __forceinline__ void xattn_stage(LAS unsigned char* lds, const bf16* src, int tid) {
    const unsigned char* g = (const unsigned char*)src + (size_t)tid * 16;
    LAS unsigned char* wb = lds + (tid >> 5) * RS + (tid & 31) * 16;
#pragma unroll
    for (int hb = 0; hb < 2; ++hb) {
        v4u r[8];
#pragma unroll
        for (int i = 0; i < 8; ++i) r[i] = *(const v4u*)(g + (hb * 8 + i) * 8192);
#pragma unroll
        for (int i = 0; i < 8; ++i) *(LAS v4u*)(wb + (hb * 8 + i) * 16 * RS) = r[i];
        asm volatile("" ::: "memory");
    }
}
__device__ __forceinline__ void xattn_unit(LAS unsigned char* lds, const bf16* QO, bf16* OO, const bf16* Kmem, const bf16* VT, int bh, int qt, int tid, int wave, int lane) {
    const int l31 = lane & 31, hh = lane >> 5, b = bh >> 2, h = bh & 3;
    const int row = b * SEQ + qt * 256 + wave * 32 + l31;
    xattn_stage<528>(lds, Kmem + (size_t)bh * 65536, tid);
    bf16x8 qf[16];
#pragma unroll
    for (int ks = 0; ks < 16; ++ks) qf[ks] = *(const bf16x8*)(QO + (size_t)row * DM + h * 256 + ks * 16 + hh * 8);
    __syncthreads();
    f32x16 st[8];
#pragma unroll
    for (int kt = 0; kt < 8; ++kt) {
        f32x16 a;
#pragma unroll
        for (int i = 0; i < 16; ++i) a[i] = 0.f;
        const LAS unsigned char* kp = lds + (kt * 32 + l31) * 528 + hh * 16;
        __builtin_amdgcn_s_setprio(1);
#pragma unroll
        for (int ks = 0; ks < 16; ++ks) a = MFMA32(*(const LAS bf16x8*)(kp + ks * 32), qf[ks], a);
        __builtin_amdgcn_s_setprio(0);
        st[kt] = a;
        asm volatile("" ::: "memory");
    }
    float mx = -3.0e38f;
#pragma unroll
    for (int kt = 0; kt < 8; ++kt)
#pragma unroll
        for (int i = 0; i < 16; ++i) mx = fmaxf(mx, st[kt][i]);
    mx = fmaxf(mx, __shfl_xor(mx, 32));
    float l = 0.f;
    bf16x8 pb[8][2];
#pragma unroll
    for (int kt = 0; kt < 8; ++kt)
#pragma unroll
        for (int s2 = 0; s2 < 2; ++s2) {
            float pv[8];
#pragma unroll
            for (int j = 0; j < 8; ++j) { pv[j] = __builtin_amdgcn_exp2f(st[kt][8 * s2 + j] - mx); l += pv[j]; }
            pb[kt][s2] = mk8(pk2(pv[0], pv[1]), pk2(pv[2], pv[3]), pk2(pv[4], pv[5]), pk2(pv[6], pv[7]));
        }
    l += __shfl_xor(l, 32);
    const float inv = 1.f / l;
    __syncthreads();
    xattn_stage<520>(lds, VT + (size_t)bh * 65536, tid);
    __syncthreads();
    bf16* orow = OO + (size_t)row * DM + h * 256;
#pragma unroll 1
    for (int dt = 0; dt < 8; ++dt) {
        f32x16 a;
#pragma unroll
        for (int i = 0; i < 16; ++i) a[i] = 0.f;
        const LAS unsigned char* vp = lds + (dt * 32 + l31) * 520 + hh * 8;
        __builtin_amdgcn_s_setprio(1);
#pragma unroll
        for (int kt = 0; kt < 8; ++kt)
#pragma unroll
            for (int s2 = 0; s2 < 2; ++s2) {
                const v2u lo = *(const LAS v2u*)(vp + (kt * 32 + 16 * s2) * 2), hi = *(const LAS v2u*)(vp + (kt * 32 + 16 * s2 + 8) * 2);
                a = MFMA32(mk8(lo.x, lo.y, hi.x, hi.y), pb[kt][s2], a);
            }
        __builtin_amdgcn_s_setprio(0);
        unsigned w[4][2];
#pragma unroll
        for (int g = 0; g < 4; ++g) { w[g][0] = pk2(a[4 * g] * inv, a[4 * g + 1] * inv); w[g][1] = pk2(a[4 * g + 2] * inv, a[4 * g + 3] * inv); }
#pragma unroll
        for (int k = 0; k < 4; k += 2) {
            const auto r0 = __builtin_amdgcn_permlane32_swap(w[k][0], w[k + 1][0], false, false);
            const auto r1 = __builtin_amdgcn_permlane32_swap(w[k][1], w[k + 1][1], false, false);
            *(v4u*)(orow + dt * 32 + 8 * k + 8 * hh) = (v4u){(unsigned)r0[0], (unsigned)r1[0], (unsigned)r0[1], (unsigned)r1[1]};
        }
    }
    __syncthreads();
}
__device__ __forceinline__ void xattn_phase(LAS unsigned char* lds, const bf16* QO, bf16* OO, const bf16* Kmem, const bf16* VT, int G, int bid, int tid, int wave, int lane) {
    for (int u = bid; u < 256; u += G) xattn_unit(lds, QO, OO, Kmem, VT, u >> 5, u & 31, tid, wave, lane);
}

#define RLX_AGENT __ATOMIC_RELAXED, __HIP_MEMORY_SCOPE_AGENT
#define XB_TMO      128
#define XB_XCNT(j)  (256  + 64 * (j))
#define XB_XSUB(j)  (1280 + 64 * (j))
#define XB_XGEN(j)  (2304 + 64 * (j))
#define XB_TOP      3328
#define XB_TOPGEN   3392
#define XCD_BAR_WORDS 3456
#define XB_SPIN_CAP (1u << 18)

__device__ __forceinline__ unsigned xb_ld(unsigned* p)              { return __hip_atomic_load(p, __ATOMIC_RELAXED, __HIP_MEMORY_SCOPE_AGENT); }
__device__ __forceinline__ unsigned xb_add(unsigned* p, unsigned v) { return __hip_atomic_fetch_add(p, v, __ATOMIC_RELAXED, __HIP_MEMORY_SCOPE_AGENT); }
__device__ __forceinline__ unsigned xb_xcc_id() { return (unsigned)__builtin_amdgcn_s_getreg((3 << 11) | 20) & 0xFu; }
#define XB_SPIN(cond, bar) do { unsigned _sp = 0; while (cond) { __builtin_amdgcn_s_sleep(1); \
    if ((++_sp & 255u) == 0u) { if (xb_ld(&(bar)[XB_TMO])) break; if (_sp > XB_SPIN_CAP) { atomicAdd(&(bar)[XB_TMO], 1u); break; } } } } while (0)

struct XcdBarrier {
    unsigned* bar; unsigned x;
    volatile LAS unsigned* st;
};

__device__ __forceinline__ XcdBarrier xcd_barrier_post(unsigned* bar, volatile LAS unsigned* st) {
    XcdBarrier b; b.bar = bar; b.x = xb_xcc_id(); b.st = st;
    if (threadIdx.x == 0) (void)xb_add(&bar[XB_XCNT(b.x)], 1u);
    return b;
}
__device__ __forceinline__ void xcd_barrier_complete(unsigned* bar, unsigned x, unsigned& nloc, unsigned& nx) {
    const unsigned G = gridDim.x * gridDim.y * gridDim.z;
    unsigned sum, cnt, mine, sp = 0u;
    for (;;) {
        sum = 0u; cnt = 0u; mine = 0u;
#pragma unroll
        for (unsigned j = 0; j < 16; ++j) { const unsigned c = xb_ld(&bar[XB_XCNT(j)]); sum += c; cnt += (c > 0u) ? 1u : 0u; mine = (j == x) ? c : mine; }
        if (sum == G) break;
        __builtin_amdgcn_s_sleep(1);
        if ((++sp & 255u) == 0u) { if (xb_ld(&bar[XB_TMO])) break; if (sp > XB_SPIN_CAP) { atomicAdd(&bar[XB_TMO], 1u); break; } }
    }
    nloc = mine > 0u ? mine : 1u; nx = cnt > 0u ? cnt : 1u;
}

__device__ __forceinline__ void xcd_barrier(const XcdBarrier& b) {
    asm volatile("s_waitcnt vmcnt(0)" ::: "memory");
    __syncthreads();
    if (threadIdx.x == 0) {
        unsigned* bar = b.bar;
        __builtin_amdgcn_s_waitcnt(0);
        unsigned nloc = b.st[0], nx = b.st[1];
        if (nloc == 0u) { xcd_barrier_complete(bar, b.x, nloc, nx); b.st[0] = nloc; b.st[1] = nx; }
        const unsigned old = xb_add(&bar[XB_XSUB(b.x)], 1u);
        const unsigned gen = old / nloc;
        if (old + 1u == (gen + 1u) * nloc) {
            __builtin_amdgcn_fence(__ATOMIC_RELEASE, "agent");
            asm volatile("s_waitcnt vmcnt(0)" ::: "memory");
            const unsigned og = xb_add(&bar[XB_TOP], 1u);
            const unsigned tg = og / nx;
            if (og + 1u == (tg + 1u) * nx) xb_add(&bar[XB_TOPGEN], 1u);
            else XB_SPIN(xb_ld(&bar[XB_TOPGEN]) == tg, bar);
            __builtin_amdgcn_fence(__ATOMIC_ACQUIRE, "agent");
            xb_add(&bar[XB_XGEN(b.x)], 1u);
            asm volatile("s_waitcnt vmcnt(0)" ::: "memory");
        } else {
            XB_SPIN(xb_ld(&bar[XB_TOPGEN]) == gen, bar);
            __builtin_amdgcn_fence(__ATOMIC_ACQUIRE, "agent");
            asm volatile("s_waitcnt vmcnt(0)" ::: "memory");
        }
    }
    __syncthreads();
}

constexpr int I_UP = 16 * 44, I_KV = 16 * 32, I_DN = 44 * 16, I_IN = 16 * 97, I_SQ = 16 * 16;
constexpr int N_EARLY = 2 * I_UP + I_KV + I_DN, N_LATE = I_IN + 3 * I_SQ + 2 * I_UP + I_DN;
struct Params { const float* in[26]; float* out; unsigned char* ws; };


__global__ void __launch_bounds__(512) fwd_kernel(Params p) {
    extern __shared__ __attribute__((aligned(16))) unsigned char lds_raw[];
    LAS unsigned char* lds = (LAS unsigned char*)lds_raw;
#define FRESH_TID() int tid = threadIdx.x; asm volatile("" : "+v"(tid)); const int lane = tid & 63, wave = __builtin_amdgcn_readfirstlane(tid >> 6); (void)lane; (void)wave
    const int G = gridDim.x, bid = blockIdx.x;
    unsigned char* ws = p.ws;
    float* rowss = (float*)(ws + WS_ROWSS); float* zbuf = (float*)(ws + WS_Z); float* decay = (float*)(ws + WS_DECAY);
    bf16* W1CAT = (bf16*)(ws + WS_W1CAT); bf16* WD1 = (bf16*)(ws + WS_WD1); bf16* WIN = (bf16*)(ws + WS_WIN); bf16* WZ = (bf16*)(ws + WS_WZ);
    bf16* WOUT = (bf16*)(ws + WS_WOUT); bf16* WQ = (bf16*)(ws + WS_WQ); bf16* WO = (bf16*)(ws + WS_WO); bf16* W2CAT = (bf16*)(ws + WS_W2CAT); bf16* WD2 = (bf16*)(ws + WS_WD2);
    bf16* KMEM = (bf16*)(ws + WS_KMEM); bf16* VTM = (bf16*)(ws + WS_VT); bf16* MIX = (bf16*)(ws + WS_MIX); bf16* RB = (bf16*)(ws + WS_R); bf16* XG = (bf16*)(ws + WS_XG);
    bf16* ST = (bf16*)p.out;
    const float* x = p.in[0]; float* out = p.out;
    volatile LAS unsigned* MISC = (volatile LAS unsigned*)(lds + LDS_MISC);
    if (threadIdx.x < 16) MISC[threadIdx.x] = 0u;
    __syncthreads();
    const XcdBarrier xbar = xcd_barrier_post((unsigned*)(ws + WS_BAR), MISC);

    {
        FRESH_TID();
        LAS float* scr = (LAS float*)(lds + wave * 16896);
        const int gw = bid * 8 + wave, NGW = G * 8;
        for (int it = gw; it < N_EARLY; it += NGW) {
            int r = it;
            if (r < I_UP) { const int kb = r / 44, n0 = (r % 44) * 64; tr_tile<64>(p.in[3], DFF, DM, kb * 64, n0, W1CAT + (size_t)((n0 >> 7) * 256 + (n0 & 127)) * DM, scr, lane); continue; } r -= I_UP;
            if (r < I_UP) { const int kb = r / 44, n0 = (r % 44) * 64; tr_tile<64>(p.in[4], DFF, DM, kb * 64, n0, W1CAT + (size_t)((n0 >> 7) * 256 + 128 + (n0 & 127)) * DM, scr, lane); continue; } r -= I_UP;
            if (r < I_KV) { const int kb = r / 32, n0 = (r % 32) * 64; tr_tile<64>(p.in[19], 2 * DM, DM, kb * 64, n0, W1CAT + (size_t)(2 * DFF + n0) * DM, scr, lane); continue; } r -= I_KV;
            { const int kb = r / 16, n0 = (r % 16) * 64; tr_tile<64>(p.in[5], DM, DFF, kb * 64, n0, WD1 + (size_t)n0 * DFF, scr, lane); }
        }
        for (int m = gw * 2; m < MTOK + BATCH * NMEM; m += NGW * 2) {
            if (m < MTOK) norm_rows2_bf16(x + (size_t)m * DM, x + (size_t)(m + 1) * DM, p.in[2], XG + (size_t)m * DM, XG + (size_t)(m + 1) * DM, lane);
            else norm_rows2_bf16(p.in[1] + (size_t)(m - MTOK) * DM, p.in[1] + (size_t)(m + 1 - MTOK) * DM, p.in[17], XG + (size_t)m * DM, XG + (size_t)(m + 1) * DM, lane);
        }
        for (int i = bid * 512 + tid; i < 3 * MTOK; i += G * 512) rowss[i] = 0.f;
    }
    xcd_barrier(xbar);

    {
        pg8::Gemm g{XG, W1CAT, MTOK + 512, 2 * DFF + 2 * DM, DM};
        OrderUpKV S; S.base.init(MTOK, 2 * DFF, G, bid); S.extra = 16;
        EpiUp E{RB, nullptr, KMEM, VTM, 2 * DFF / 256};
        pg8::gemm_phase<EpiUp, OrderUpKV, true, true>(lds, g, S, E);
        constexpr int NU = 2 * DFF / 256 * (MTOK / 256) + 16;
        const int rem = NU % G, nsp = rem ? G - rem : G, si = rem ? bid - rem : bid;
        if (si >= 0) {
            FRESH_TID();
            LAS float* scr = (LAS float*)(lds + wave * 16896);
            for (int it = si * 8 + wave; it < N_LATE; it += nsp * 8) {
                int r = it;
                if (r < I_IN) { const int kb = r / 97, nb = r % 97, n0 = nb * 32;
                    bf16* dst = nb < 48 ? WIN + (size_t)n0 * DM : (nb == 48 ? WZ : WIN + (size_t)(n0 - 32) * DM);
                    tr_tile<32>(p.in[7], DIN, DM, kb * 64, n0, dst, scr, lane, p.in[6]); continue; } r -= I_IN;
                if (r < I_SQ) { const int kb = r / 16, n0 = (r % 16) * 64; tr_tile<64>(p.in[15], DM, DM, kb * 64, n0, WOUT + (size_t)n0 * DM, scr, lane); continue; } r -= I_SQ;
                if (r < I_SQ) { const int kb = r / 16, n0 = (r % 16) * 64; tr_tile<64>(p.in[18], DM, DM, kb * 64, n0, WQ + (size_t)n0 * DM, scr, lane, p.in[16]); continue; } r -= I_SQ;
                if (r < I_SQ) { const int kb = r / 16, n0 = (r % 16) * 64; tr_tile<64>(p.in[20], DM, DM, kb * 64, n0, WO + (size_t)n0 * DM, scr, lane); continue; } r -= I_SQ;
                if (r < I_UP) { const int kb = r / 44, n0 = (r % 44) * 64; tr_tile<64>(p.in[22], DFF, DM, kb * 64, n0, W2CAT + (size_t)((n0 >> 7) * 256 + (n0 & 127)) * DM, scr, lane, p.in[21]); continue; } r -= I_UP;
                if (r < I_UP) { const int kb = r / 44, n0 = (r % 44) * 64; tr_tile<64>(p.in[23], DFF, DM, kb * 64, n0, W2CAT + (size_t)((n0 >> 7) * 256 + 128 + (n0 & 127)) * DM, scr, lane, p.in[21]); continue; } r -= I_UP;
                { const int kb = r / 16, n0 = (r % 16) * 64; tr_tile<64>(p.in[24], DM, DFF, kb * 64, n0, WD2 + (size_t)n0 * DFF, scr, lane); }
            }
        }
    }
    xcd_barrier(xbar);
    {
        pg8::Gemm g{RB, WD1, MTOK, DM, DFF};
        pg8::StaticOrder S; S.init(MTOK, DM, G, bid);
        EpiResB E{x, XG, rowss, 0.5f};
        pg8::gemm_phase<EpiResB, pg8::StaticOrder, true, true>(lds, g, S, E);
    }
    xcd_barrier(xbar);
    {
        {
        pg8::Gemm g{XG, WIN, MTOK, NPROJ, DM};
        pg8::StaticOrder S; S.init(MTOK, NPROJ, G, bid);
        EpiScale E{RB, NPROJ, rowss, 1.f, true};
        pg8::gemm_phase<EpiScale, pg8::StaticOrder, true, true>(lds, g, S, E);
        }
        FRESH_TID();
        const int fr = lane & 15, fq = lane >> 4;
        for (int rb = bid; rb < MTOK / 64; rb += G) {
            const int row0 = rb * 64 + (wave >> 1) * 16, zc0 = (wave & 1) * 16;
            f32x4 acc0 = {0.f, 0.f, 0.f, 0.f}, acc1 = {0.f, 0.f, 0.f, 0.f};
            const float rsq = rowss[row0 + fr];
#pragma unroll 1
            for (int half = 0; half < 2; ++half) {
                v4u rg[12];
#pragma unroll
                for (int i = 0; i < 12; ++i) {
                    const int c = tid + 512 * i, row = c >> 6, c16 = c & 63;
                    const bf16* src = (row < 64 ? XG + (size_t)(rb * 64 + row) * DM : WZ + (size_t)(row - 64) * DM) + half * 512 + c16 * 8;
                    rg[i] = *(const v4u*)src;
                }
#pragma unroll
                for (int i = 0; i < 12; ++i) { const int c = tid + 512 * i; *(LAS v4u*)(lds + (c >> 6) * 1040 + (c & 63) * 16) = rg[i]; }
                __syncthreads();
                const LAS unsigned char* ap = lds + (64 + zc0 + fr) * 1040 + fq * 16; const LAS unsigned char* bp = lds + ((wave >> 1) * 16 + fr) * 1040 + fq * 16;
#pragma unroll
                for (int i = 0; i < 16; i += 2) {
                    acc0 = MFMA16(*(const LAS bf16x8*)(ap + i * 64), *(const LAS bf16x8*)(bp + i * 64), acc0);
                    acc1 = MFMA16(*(const LAS bf16x8*)(ap + (i + 1) * 64), *(const LAS bf16x8*)(bp + (i + 1) * 64), acc1);
                }
                __syncthreads();
            }
            const float rs = rsqrtf(rsq * (1.f / DM) + EPS);
            *(f32x4*)(zbuf + (size_t)(row0 + fr) * 32 + zc0 + fq * 4) = (acc0 + acc1) * rs;
        }
    }
    xcd_barrier(xbar);
    { FRESH_TID(); gla_g1(lds, zbuf, RB, p.in[8], p.in[9], p.in[10], p.in[11], decay, ST, p.in[13], p.in[14], MIX, G, bid, tid, wave, lane); }
    xcd_barrier(xbar);
    { FRESH_TID(); gla_g2(ST, decay, G, bid, tid); }
    xcd_barrier(xbar);
    { FRESH_TID(); gla_g3(lds, zbuf, RB, p.in[8], p.in[9], p.in[10], p.in[11], ST, p.in[12], MIX, G, bid, tid, wave, lane); }
    xcd_barrier(xbar);
    {
        pg8::Gemm g{MIX, WOUT, MTOK, DM, DM};
        pg8::StaticOrder S; S.init(MTOK, DM, G, bid);
        EpiResB E{nullptr, XG, rowss + MTOK, 1.f};
        pg8::gemm_phase<EpiResB, pg8::StaticOrder, true, true>(lds, g, S, E);
    }
    xcd_barrier(xbar);
    {
        pg8::Gemm g{XG, WQ, MTOK, DM, DM};
        pg8::StaticOrder S; S.init(MTOK, DM, G, bid);
        EpiScale E{MIX, DM, rowss + MTOK, 0.0625f * 1.4426950408889634f, false};
        pg8::gemm_phase<EpiScale, pg8::StaticOrder, true, true>(lds, g, S, E);
    }
    xcd_barrier(xbar);
    { FRESH_TID(); xattn_phase(lds, MIX, RB, KMEM, VTM, G, bid, tid, wave, lane); }
    xcd_barrier(xbar);
    {
        pg8::Gemm g{RB, WO, MTOK, DM, DM};
        pg8::StaticOrder S; S.init(MTOK, DM, G, bid);
        EpiResB E{nullptr, XG, rowss + 2 * MTOK, 1.f};
        pg8::gemm_phase<EpiResB, pg8::StaticOrder, true, true>(lds, g, S, E);
    }
    xcd_barrier(xbar);
    {
        pg8::Gemm g{XG, W2CAT, MTOK, 2 * DFF, DM};
        pg8::StaticOrder S; S.init(MTOK, 2 * DFF, G, bid);
        EpiUp E{RB, rowss + 2 * MTOK, nullptr, nullptr, 2 * DFF / 256};
        pg8::gemm_phase<EpiUp, pg8::StaticOrder, true, true>(lds, g, S, E);
    }
    xcd_barrier(xbar);
    if (G == MTOK / 256 * (DM / 256)) {
        pg8::Gemm g{RB, WD2, MTOK, DM, DFF};
        pg8::StaticOrder S; S.init(MTOK, DM, G, bid);
        EpiResNorm E{XG, out, p.in[25], 0.5f, (float*)(ws + WS_PART), (unsigned*)(ws + WS_BAR + 16384)};
        pg8::gemm_phase<EpiResNorm, pg8::StaticOrder, false, true>(lds, g, S, E);
    } else {
        {
            pg8::Gemm g{RB, WD2, MTOK, DM, DFF};
            pg8::StaticOrder S; S.init(MTOK, DM, G, bid);
            EpiResF E{XG, out, 0.5f};
            pg8::gemm_phase<EpiResF, pg8::StaticOrder, true, true>(lds, g, S, E);
        }
        xcd_barrier(xbar);
        {
            FRESH_TID();
            const int gw = bid * 8 + wave, NGW = G * 8;
            for (int m = gw; m < MTOK; m += NGW) {
                f32x4* xr = (f32x4*)(out + (size_t)m * DM) + lane; const f32x4* gr = (const f32x4*)p.in[25] + lane;
                f32x4 v[4]; float s = 0.f;
#pragma unroll
                for (int j = 0; j < 4; ++j) { v[j] = xr[64 * j]; s += (v[j][0] * v[j][0] + v[j][1] * v[j][1]) + (v[j][2] * v[j][2] + v[j][3] * v[j][3]); }
                const float rs = rsqrtf(wave_sum(s) * (1.f / DM) + EPS);
#pragma unroll
                for (int j = 0; j < 4; ++j) xr[64 * j] = v[j] * rs * gr[64 * j];
            }
        }
    }
}

extern "C" void kernel_launch(void* const* d_in, const int* in_sizes, int n_in, void* d_out, int out_size, void* d_ws, size_t ws_size, hipStream_t stream) {
    static int grid_blocks = 0;
    if (!grid_blocks) {
        if (n_in != 26 || out_size != MTOK * DM || ws_size < WS_END) { fprintf(stderr, "kernel_launch: unexpected shapes n_in=%d out=%d ws=%zu\n", n_in, out_size, ws_size); grid_blocks = -1; return; }
        int dev = 0, cus = 0, per_cu = 0;
        hipGetDevice(&dev);
        hipDeviceGetAttribute(&cus, hipDeviceAttributeMultiprocessorCount, dev);
        hipFuncSetAttribute((const void*)fwd_kernel, hipFuncAttributeMaxDynamicSharedMemorySize, LDS_BYTES);
        hipOccupancyMaxActiveBlocksPerMultiprocessor(&per_cu, (const void*)fwd_kernel, 512, LDS_BYTES);
        if (per_cu < 1) { fprintf(stderr, "kernel_launch: occupancy query says %d blocks/CU\n", per_cu); per_cu = 1; }
        grid_blocks = cus * per_cu;
    }
    if (grid_blocks < 0) return;
    if (hipMemsetAsync((char*)d_ws + WS_BAR, 0, 32768, stream) != hipSuccess) { fprintf(stderr, "kernel_launch: memset failed\n"); return; }
    Params p{};
    for (int i = 0; i < 26; ++i) p.in[i] = (const float*)d_in[i];
    p.out = (float*)d_out; p.ws = (unsigned char*)d_ws;
    void* args[] = {&p};
    hipError_t e = hipLaunchCooperativeKernel((const void*)fwd_kernel, dim3(grid_blocks), dim3(512), args, LDS_BYTES, stream);
    if (e != hipSuccess) fprintf(stderr, "cooperative launch failed: %s (grid %d)\n", hipGetErrorString(e), grid_blocks);
}
```

```cpp
#include <hip/hip_runtime.h>
#include <cstdio>
#include <cstdint>
namespace pg8 {
#define PG8_LAS __attribute__((address_space(3)))
typedef unsigned short bf16_t;
typedef short bf16x8 __attribute__((ext_vector_type(8)));
typedef float f32x4 __attribute__((ext_vector_type(4)));
typedef unsigned u32x4 __attribute__((ext_vector_type(4)));
constexpr int BM = 256, BK = 64, HALF = 128, HTB = HALF * BK * 2  , STAGE_BYTES = 8 * HTB, NXCD = 8, WGM = 8;

__host__ __device__ __forceinline__ int lds_byte(int r, int c) { const int st = (r >> 4) * 2 + (c >> 5), rr = r & 15, cc = c & 31, ob = rr * 64 + cc * 2; return st * 1024 + (ob ^ (((ob >> 9) & 1) << 5)); }
__host__ __device__ __forceinline__ void stage_rc(int b, int& R, int& C) { const int st = b / 1024, sb = b % 1024, swz = sb ^ (((sb >> 9) & 1) << 5); R = (st >> 1) * 16 + swz / 64; C = (st & 1) * 32 + (swz % 64) / 2; }
__host__ __device__ __forceinline__ int perm32(int rho) { const int n = rho >> 4, i = rho & 15; return 8 * (i >> 2) + 4 * n + (i & 3); }

struct Unit { int pm, pn; };
struct Gemm { const bf16_t* A; const bf16_t* Bt; int M, N, K; };

struct StaticOrder {
    int nM, nN, nwg, G, c;
    __host__ __device__ void init(int M, int N, int G_, int c_) { nM = M / BM; nN = N / BM; nwg = nM * nN; G = G_; c = c_; }
    __host__ __device__ bool next(int i, Unit& u) const {
        const long L = (long)i * G + c; if (L >= nwg) return false;
        int wgid = (int)L; { const int q = nwg / NXCD, r = nwg % NXCD, xcd = wgid % NXCD, off = wgid / NXCD; wgid = (xcd < r ? xcd * (q + 1) : r * (q + 1) + (xcd - r) * q) + off; }
        const int nig = WGM * nN, gid = wgid / nig, fm = gid * WGM, gsz = (nM - fm) < WGM ? (nM - fm) : WGM;
        u.pm = fm + ((wgid % nig) % gsz); u.pn = (wgid % nig) / gsz; return true;
    }
    __device__ __forceinline__ void a_ready(const Unit&) const {}
    __device__ __forceinline__ void done(const Unit&) const {}
};

__device__ __forceinline__ unsigned cvt_pk_bf16(float lo, float hi) { unsigned r; asm volatile("v_cvt_pk_bf16_f32 %0, %1, %2" : "=v"(r) : "v"(lo), "v"(hi)); return r; }
template <class Epi, class Sched, bool ALIGN_EPI = false, bool SP2 = false>
__device__ __forceinline__ void gemm_phase(PG8_LAS unsigned char* lds, const Gemm g, const Sched& S, const Epi& E) {
    int tid_l = threadIdx.x; asm volatile("" : "+v"(tid_l));
    const int tid = tid_l, wid = __builtin_amdgcn_readfirstlane(tid >> 6), lane = tid & 63, wr = wid >> 2, wc = wid & 3, fr = lane & 15, fq = lane >> 4;
    const int K = g.K, nt = K / BK;
    unsigned voffA[2], voffB[2];
#pragma unroll
    for (int i = 0; i < 2; ++i) { int R, C; stage_rc(tid * 16 + i * 8192, R, C); const int Rb = Epi::PERM ? ((R & ~31) + perm32(R & 31)) : R;
        voffA[i] = (unsigned)(R * K + C) * 2u; voffB[i] = (unsigned)(Rb * K + C) * 2u; }
    const size_t kstep = (size_t)(BK * 2);
    const size_t hstep = (size_t)HALF * K * 2;
    const size_t tstep = 2 * hstep;
    const unsigned ldsw = (unsigned)wid * 1024u;
    const int aoff = lds_byte(wr * 64 + fr, fq * 8), boff = lds_byte(wc * 32 + fr, fq * 8);
#define PG8_SA(b, h) (((b) * 2 + (h)) * HTB)
#define PG8_SB(b, h) ((4 + (b) * 2 + (h)) * HTB)
#define PG8_STAGE(bufoff, gbase, voff) do { _Pragma("unroll") for (int _i = 0; _i < 2; ++_i) \
        __builtin_amdgcn_global_load_lds((const unsigned*)((const char*)(gbase) + (voff)[_i]), (PG8_LAS unsigned*)(lds + (bufoff) + ldsw + _i * 8192), 16, 0, 0); } while (0)
#define PG8_LDA(dst, b, h) do { _Pragma("unroll") for (int m = 0; m < 4; ++m) _Pragma("unroll") for (int k = 0; k < 2; ++k) dst[m][k] = *(const PG8_LAS bf16x8*)(lds + PG8_SA(b, h) + aoff + m * 2048 + k * 1024); } while (0)
#define PG8_LDB(dst, b, h) do { _Pragma("unroll") for (int n = 0; n < 2; ++n) _Pragma("unroll") for (int k = 0; k < 2; ++k) dst[n][k] = *(const PG8_LAS bf16x8*)(lds + PG8_SB(b, h) + boff + n * 2048 + k * 1024); } while (0)
#define PG8_MMA(ai, bj, At, Bt) do { __builtin_amdgcn_s_setprio(1); _Pragma("unroll") for (int m = 0; m < 4; ++m) _Pragma("unroll") for (int n = 0; n < 2; ++n) _Pragma("unroll") for (int k = 0; k < 2; ++k) \
        acc[ai][bj][m][n] = __builtin_amdgcn_mfma_f32_16x16x32_bf16(Bt[n][k], At[m][k], acc[ai][bj][m][n], 0, 0, 0); __builtin_amdgcn_s_setprio(0); } while (0)
#define PG8_WAIT_V(n) asm volatile("s_waitcnt vmcnt(" #n ")" ::: "memory")
#define PG8_WAIT_L(n) asm volatile("s_waitcnt lgkmcnt(" #n ")" ::: "memory")
#define PG8_BAR __builtin_amdgcn_s_barrier()
#define PG8_SCHED __builtin_amdgcn_sched_barrier(0)
    Unit cur, nxt; int ui = 0;
    if (!S.next(0, cur)) return;
    f32x4 acc[2][2][4][2];
#pragma unroll
    for (int a = 0; a < 2; ++a)
#pragma unroll
        for (int b = 0; b < 2; ++b)
#pragma unroll
            for (int m = 0; m < 4; ++m)
#pragma unroll
                for (int n = 0; n < 2; ++n) acc[a][b][m][n] = (f32x4){0.f, 0.f, 0.f, 0.f};
    bf16x8 At[4][2], B0[2][2], B1[2][2];
    const char* cA = (const char*)g.A + (size_t)cur.pm * tstep; const char* cB = (const char*)g.Bt + (size_t)cur.pn * tstep;
    S.a_ready(cur);
    if constexpr (SP2) {
        PG8_STAGE(PG8_SB(0, 0), cB, voffB); PG8_STAGE(PG8_SB(0, 1), cB + hstep, voffB); PG8_STAGE(PG8_SA(0, 0), cA, voffA); PG8_STAGE(PG8_SA(0, 1), cA + hstep, voffA);
        if (wr == 1) PG8_BAR;
        PG8_WAIT_V(2); PG8_BAR;
        PG8_STAGE(PG8_SB(1, 0), cB + kstep, voffB); PG8_STAGE(PG8_SA(1, 0), cA + kstep, voffA); PG8_STAGE(PG8_SB(1, 1), cB + hstep + kstep, voffB);
        PG8_WAIT_V(6); PG8_BAR;
    } else {
        PG8_STAGE(PG8_SB(0, 0), cB, voffB); PG8_STAGE(PG8_SA(0, 0), cA, voffA); PG8_STAGE(PG8_SB(0, 1), cB + hstep, voffB); PG8_STAGE(PG8_SA(0, 1), cA + hstep, voffA);
        if (wr == 1) PG8_BAR;
        PG8_WAIT_V(4); PG8_BAR;
        PG8_STAGE(PG8_SB(1, 0), cB + kstep, voffB); PG8_STAGE(PG8_SA(1, 0), cA + kstep, voffA); PG8_STAGE(PG8_SB(1, 1), cB + hstep + kstep, voffB);
        PG8_WAIT_V(6); PG8_BAR;
    }
    for (;;) {
        const bool has_next = S.next(ui + 1, nxt);
        const char* nA = has_next ? (const char*)g.A + (size_t)nxt.pm * tstep : cA; const char* nB = has_next ? (const char*)g.Bt + (size_t)nxt.pn * tstep : cB;
        for (int t = 0; t < nt; t += 2) {
            const bool last = (t == nt - 2);
            const char* a1 = cA + (size_t)(t + 1) * kstep;
            const char* a2 = last ? nA : cA + (size_t)(t + 2) * kstep; const char* b2 = last ? nB : cB + (size_t)(t + 2) * kstep;
            const char* a3 = a2 + kstep; const char* b3 = b2 + kstep;
            if (last && has_next) S.a_ready(nxt);
            if constexpr (SP2) {
            PG8_LDB(B0, 0, 0); PG8_LDB(B1, 0, 1); PG8_SCHED; PG8_LDA(At, 0, 0); PG8_STAGE(PG8_SA(1, 1), a1 + hstep, voffA);
            PG8_WAIT_V(8); PG8_WAIT_L(0); PG8_BAR; PG8_MMA(0, 0, At, B0); PG8_MMA(0, 1, At, B1); PG8_BAR; PG8_SCHED;
            PG8_LDA(At, 0, 1); PG8_STAGE(PG8_SB(0, 0), b2, voffB); PG8_STAGE(PG8_SB(0, 1), b2 + hstep, voffB); PG8_STAGE(PG8_SA(0, 0), a2, voffA);
            PG8_WAIT_V(8); PG8_WAIT_L(0); PG8_BAR; PG8_MMA(1, 0, At, B0); PG8_MMA(1, 1, At, B1); PG8_BAR; PG8_SCHED;
            PG8_LDB(B0, 1, 0); PG8_LDB(B1, 1, 1); PG8_SCHED; PG8_LDA(At, 1, 0); PG8_STAGE(PG8_SA(0, 1), a2 + hstep, voffA);
            PG8_WAIT_V(8); PG8_WAIT_L(0); PG8_BAR; PG8_MMA(0, 0, At, B0); PG8_MMA(0, 1, At, B1); PG8_BAR; PG8_SCHED;
            PG8_LDA(At, 1, 1); PG8_STAGE(PG8_SB(1, 0), b3, voffB); PG8_STAGE(PG8_SB(1, 1), b3 + hstep, voffB); PG8_STAGE(PG8_SA(1, 0), a3, voffA);
            PG8_WAIT_V(8); PG8_WAIT_L(0); PG8_BAR; PG8_MMA(1, 0, At, B0); PG8_MMA(1, 1, At, B1); PG8_BAR; PG8_SCHED;
            } else {
            PG8_LDB(B0, 0, 0); PG8_SCHED; PG8_LDA(At, 0, 0); PG8_STAGE(PG8_SA(1, 1), a1 + hstep, voffA);
            PG8_WAIT_L(8); PG8_BAR; PG8_WAIT_L(0); PG8_MMA(0, 0, At, B0); PG8_BAR; PG8_SCHED;
            PG8_LDB(B1, 0, 1); PG8_STAGE(PG8_SB(0, 0), b2, voffB);
            PG8_BAR; PG8_WAIT_L(0); PG8_MMA(0, 1, At, B1); PG8_BAR;
            PG8_LDA(At, 0, 1); PG8_STAGE(PG8_SA(0, 0), a2, voffA);
            PG8_BAR; PG8_WAIT_L(0); PG8_MMA(1, 0, At, B0); PG8_BAR; PG8_SCHED;
            PG8_STAGE(PG8_SB(0, 1), b2 + hstep, voffB);
            PG8_WAIT_V(6); PG8_BAR; PG8_MMA(1, 1, At, B1); PG8_BAR;
            PG8_LDB(B0, 1, 0); PG8_SCHED; PG8_LDA(At, 1, 0); PG8_STAGE(PG8_SA(0, 1), a2 + hstep, voffA);
            PG8_WAIT_L(8); PG8_BAR; PG8_WAIT_L(0); PG8_MMA(0, 0, At, B0); PG8_BAR; PG8_SCHED;
            PG8_LDB(B1, 1, 1); PG8_STAGE(PG8_SB(1, 0), b3, voffB);
            PG8_BAR; PG8_WAIT_L(0); PG8_MMA(0, 1, At, B1); PG8_BAR;
            PG8_LDA(At, 1, 1); PG8_STAGE(PG8_SA(1, 0), a3, voffA);
            PG8_BAR; PG8_WAIT_L(0); PG8_MMA(1, 0, At, B0); PG8_BAR; PG8_SCHED;
            PG8_STAGE(PG8_SB(1, 1), b3 + hstep, voffB);
            PG8_WAIT_V(6); PG8_BAR; PG8_MMA(1, 1, At, B1); PG8_BAR;
            }
        }
        if constexpr (ALIGN_EPI) { if (wr == 0) PG8_BAR; }
        if constexpr (!Epi::AFTER_DRAIN) { E(acc, cur, wr, wc, fr, fq); S.done(cur); }
        if (!has_next) break;
#pragma unroll
        for (int a = 0; a < 2; ++a)
#pragma unroll
            for (int b = 0; b < 2; ++b)
#pragma unroll
                for (int m = 0; m < 4; ++m)
#pragma unroll
                    for (int n = 0; n < 2; ++n) acc[a][b][m][n] = (f32x4){0.f, 0.f, 0.f, 0.f};
        cur = nxt; cA = nA; cB = nB; ++ui;
        if constexpr (ALIGN_EPI) { if (wr == 1) PG8_BAR; }
    }
    PG8_WAIT_V(0);
    if constexpr (!ALIGN_EPI) { if (wr == 0) PG8_BAR; }
    PG8_BAR;
    if constexpr (Epi::AFTER_DRAIN) { E.fused(acc, cur, wr, wc, fr, fq, lds, wid, lane); S.done(cur); }
#undef PG8_SA
#undef PG8_SB
#undef PG8_STAGE
#undef PG8_LDA
#undef PG8_LDB
#undef PG8_MMA
#undef PG8_WAIT_V
#undef PG8_WAIT_L
#undef PG8_BAR
#undef PG8_SCHED
}
}

constexpr int DM = 1024, BATCH = 2, SEQ = 8192, MTOK = BATCH * SEQ, NMEM = 256, DFF = 2816, DIN = 3104, NPROJ = 3072;
constexpr float EPS = 1e-6f;
constexpr size_t MiB = 1u << 20;
constexpr size_t WS_ROWSS = 0;
constexpr size_t WS_Z = 1 * MiB;
constexpr size_t WS_DECAY = 3 * MiB;
constexpr size_t WS_W1CAT = 4 * MiB;
constexpr size_t WS_WD1 = 19 * MiB;
constexpr size_t WS_WIN = 25 * MiB;
constexpr size_t WS_WZ = 31 * MiB;
constexpr size_t WS_WOUT = 32 * MiB, WS_WQ = 34 * MiB, WS_WO = 36 * MiB;
constexpr size_t WS_W2CAT = 38 * MiB;
constexpr size_t WS_WD2 = 49 * MiB;
constexpr size_t WS_KMEM = 55 * MiB;
constexpr size_t WS_VT = 56 * MiB;
constexpr size_t WS_MIX = 58 * MiB;
constexpr size_t WS_R = 90 * MiB;
constexpr size_t WS_XG = 186 * MiB;
constexpr size_t WS_ST = 186 * MiB;
constexpr size_t WS_END = 256 * MiB;
constexpr size_t WS_PART = 256 * 1024;
constexpr size_t WS_BAR = 768 * 1024;
constexpr int LDS_MISC = 135168;
constexpr int LDS_BYTES = LDS_MISC + 64;

#define LAS __attribute__((address_space(3)))
typedef unsigned short bf16;
typedef unsigned v4u __attribute__((ext_vector_type(4)));
typedef unsigned v2u __attribute__((ext_vector_type(2)));
typedef float f32x4 __attribute__((ext_vector_type(4)));
typedef short bf16x8 __attribute__((ext_vector_type(8)));
#define LDS_WAIT() asm volatile("s_waitcnt lgkmcnt(0)" ::: "memory")

typedef float f32x2v __attribute__((ext_vector_type(2)));
typedef __bf16 bf16x2v __attribute__((ext_vector_type(2)));
__device__ __forceinline__ unsigned pk2(float lo, float hi) { const f32x2v v = {lo, hi}; const bf16x2v b = __builtin_convertvector(v, bf16x2v); return __builtin_bit_cast(unsigned, b); }
__device__ __forceinline__ float bflo(unsigned w) { return __uint_as_float(w << 16); }
__device__ __forceinline__ float bfhi(unsigned w) { return __uint_as_float(w & 0xffff0000u); }
__device__ __forceinline__ float silu_f(float x) { return x * __builtin_amdgcn_rcpf(1.f + __expf(-x)); }
__device__ __forceinline__ float logsig_f(float a) { return fminf(a, 0.f) - __logf(1.f + __expf(-fabsf(a))); }
__device__ __forceinline__ float wave_sum(float v) {
#pragma unroll
    for (int o = 1; o < 64; o <<= 1) v += __shfl_xor(v, o);
    return v;
}
__device__ __forceinline__ bf16x8 mk8(unsigned a, unsigned b, unsigned c, unsigned d) { v4u w = {a, b, c, d}; return __builtin_bit_cast(bf16x8, w); }
#define MFMA16(a, b, c) __builtin_amdgcn_mfma_f32_16x16x32_bf16((a), (b), (c), 0, 0, 0)

struct EpiUp {
    static constexpr bool PERM = true, AFTER_DRAIN = false;
    bf16* act; const float* rowss; bf16* Kmem; bf16* VT; int npn_main;
    __device__ __forceinline__ void operator()(const pg8::f32x4 (&acc)[2][2][4][2], const pg8::Unit& u, int wr, int wc, int fr, int fq) const {
        if (u.pn < npn_main) {
            const int row0 = u.pm * 256 + wr * 64 + fr, col0 = u.pn * 128 + wc * 32 + 8 * fq;
            float rsv[2][4];
#pragma unroll
            for (int ai = 0; ai < 2; ++ai)
#pragma unroll
                for (int m = 0; m < 4; ++m) rsv[ai][m] = rowss ? rowss[row0 + ai * 128 + m * 16] : 0.f;
#pragma unroll
            for (int ai = 0; ai < 2; ++ai)
#pragma unroll
                for (int m = 0; m < 4; ++m) {
                    const int r = row0 + ai * 128 + m * 16;
                    const float rs = rowss ? rsqrtf(rsv[ai][m] * (1.f / DM) + EPS) : 1.f;
                    float o[8];
#pragma unroll
                    for (int n = 0; n < 2; ++n)
#pragma unroll
                        for (int i = 0; i < 4; ++i) { const float g = acc[ai][0][m][n][i] * rs, uu = acc[ai][1][m][n][i] * rs; o[n * 4 + i] = silu_f(g) * uu; }
                    v4u w = {pk2(o[0], o[1]), pk2(o[2], o[3]), pk2(o[4], o[5]), pk2(o[6], o[7])};
                    *(v4u*)(act + (size_t)r * DFF + col0) = w;
                }
        } else {
            const int hsel = u.pn - npn_main;
            const int mt0 = (u.pm - MTOK / 256) * 256 + wr * 64 + fr;
#pragma unroll
            for (int ai = 0; ai < 2; ++ai)
#pragma unroll
                for (int m = 0; m < 4; ++m) {
                    const int mt = mt0 + ai * 128 + m * 16, b = mt >> 8, key = mt & 255;
#pragma unroll
                    for (int bj = 0; bj < 2; ++bj) {
                        const int d0 = bj * 128 + wc * 32 + 8 * fq;
                        const f32x4 v0 = acc[ai][bj][m][0], v1 = acc[ai][bj][m][1];
                        if (hsel < 4) {
                            v4u w = {pk2(v0[0], v0[1]), pk2(v0[2], v0[3]), pk2(v1[0], v1[1]), pk2(v1[2], v1[3])};
                            *(v4u*)(Kmem + ((size_t)((b * 4 + hsel) * 256 + key)) * 256 + d0) = w;
                        } else {
                            bf16* dst = VT + ((size_t)((b * 4 + hsel - 4) * 256 + d0)) * 256 + key;
                            const unsigned w0 = pk2(v0[0], v0[1]), w1 = pk2(v0[2], v0[3]), w2 = pk2(v1[0], v1[1]), w3 = pk2(v1[2], v1[3]);
                            dst[0 * 256] = (bf16)(w0 & 0xffffu); dst[1 * 256] = (bf16)(w0 >> 16); dst[2 * 256] = (bf16)(w1 & 0xffffu); dst[3 * 256] = (bf16)(w1 >> 16);
                            dst[4 * 256] = (bf16)(w2 & 0xffffu); dst[5 * 256] = (bf16)(w2 >> 16); dst[6 * 256] = (bf16)(w3 & 0xffffu); dst[7 * 256] = (bf16)(w3 >> 16);
                        }
                    }
                }
        }
    }
};
struct EpiResF {
    static constexpr bool PERM = false, AFTER_DRAIN = false;
    const bf16* base; float* out; float alpha;
    __device__ __forceinline__ void operator()(const pg8::f32x4 (&acc)[2][2][4][2], const pg8::Unit& u, int wr, int wc, int fr, int fq) const {
        const int row0 = u.pm * 256 + wr * 64 + fr, col0 = u.pn * 256 + wc * 32 + 4 * fq;
#pragma unroll
        for (int ai = 0; ai < 2; ++ai)
#pragma unroll
            for (int m = 0; m < 4; ++m) {
                const size_t off = (size_t)(row0 + ai * 128 + m * 16) * DM + col0;
#pragma unroll
                for (int bj = 0; bj < 2; ++bj)
#pragma unroll
                    for (int n = 0; n < 2; ++n) {
                        const v2u bw = *(const v2u*)(base + off + bj * 128 + n * 16);
                        const f32x4 bs = {bflo(bw.x), bfhi(bw.x), bflo(bw.y), bfhi(bw.y)};
                        *(f32x4*)(out + off + bj * 128 + n * 16) = bs + acc[ai][bj][m][n] * alpha;
                    }
            }
    }
};
struct EpiResB {
    static constexpr bool PERM = true, AFTER_DRAIN = false;
    const float* basef; bf16* xs; float* rowss; float alpha;
    __device__ __forceinline__ void operator()(const pg8::f32x4 (&acc)[2][2][4][2], const pg8::Unit& u, int wr, int wc, int fr, int fq) const {
        const int row0 = u.pm * 256 + wr * 64 + fr, col0 = u.pn * 256 + wc * 32 + 8 * fq;
#pragma unroll
        for (int ai = 0; ai < 2; ++ai) {
            f32x4 b0[4][2], b1[4][2];
            if (basef) {
#pragma unroll
                for (int m = 0; m < 4; ++m)
#pragma unroll
                    for (int bj = 0; bj < 2; ++bj) { const float* bp = basef + (size_t)(row0 + ai * 128 + m * 16) * DM + col0 + bj * 128; b0[m][bj] = __builtin_nontemporal_load((const f32x4*)bp); b1[m][bj] = __builtin_nontemporal_load((const f32x4*)(bp + 4));     }
            } else {
                v4u bw[4][2];
#pragma unroll
                for (int m = 0; m < 4; ++m)
#pragma unroll
                    for (int bj = 0; bj < 2; ++bj) bw[m][bj] = *(const v4u*)(xs + (size_t)(row0 + ai * 128 + m * 16) * DM + col0 + bj * 128);
#pragma unroll
                for (int m = 0; m < 4; ++m)
#pragma unroll
                    for (int bj = 0; bj < 2; ++bj) { const v4u w = bw[m][bj]; b0[m][bj] = (f32x4){bflo(w.x), bfhi(w.x), bflo(w.y), bfhi(w.y)}; b1[m][bj] = (f32x4){bflo(w.z), bfhi(w.z), bflo(w.w), bfhi(w.w)}; }
            }
#pragma unroll
            for (int m = 0; m < 4; ++m) {
                const int r = row0 + ai * 128 + m * 16; const size_t off = (size_t)r * DM + col0; float ss = 0.f;
#pragma unroll
                for (int bj = 0; bj < 2; ++bj) {
                    const f32x4 v0 = b0[m][bj] + acc[ai][bj][m][0] * alpha, v1 = b1[m][bj] + acc[ai][bj][m][1] * alpha;
                    ss += ((v0[0] * v0[0] + v0[1] * v0[1]) + (v0[2] * v0[2] + v0[3] * v0[3])) + ((v1[0] * v1[0] + v1[1] * v1[1]) + (v1[2] * v1[2] + v1[3] * v1[3]));
                    *(v4u*)(xs + off + bj * 128) = (v4u){pk2(v0[0], v0[1]), pk2(v0[2], v0[3]), pk2(v1[0], v1[1]), pk2(v1[2], v1[3])};
                }
                ss += __shfl_xor(ss, 16); ss += __shfl_xor(ss, 32); if (fq == 0) atomicAdd(rowss + r, ss);
            }
        }
    }
};
struct EpiScale {
    static constexpr bool PERM = true, AFTER_DRAIN = false;
    bf16* O; int ldc; const float* rowss; float scale; bool nt;
    __device__ __forceinline__ void operator()(const pg8::f32x4 (&acc)[2][2][4][2], const pg8::Unit& u, int wr, int wc, int fr, int fq) const {
        const int row0 = u.pm * 256 + wr * 64 + fr, col0 = u.pn * 256 + wc * 32 + 8 * fq;
        float rsv[2][4];
#pragma unroll
        for (int ai = 0; ai < 2; ++ai)
#pragma unroll
            for (int m = 0; m < 4; ++m) rsv[ai][m] = rowss[row0 + ai * 128 + m * 16];
#pragma unroll
        for (int ai = 0; ai < 2; ++ai)
#pragma unroll
            for (int m = 0; m < 4; ++m) {
                const int r = row0 + ai * 128 + m * 16;
                const float rs = rsqrtf(rsv[ai][m] * (1.f / DM) + EPS) * scale;
#pragma unroll
                for (int bj = 0; bj < 2; ++bj) {
                    const f32x4 v0 = acc[ai][bj][m][0] * rs, v1 = acc[ai][bj][m][1] * rs;
                    v4u w = {pk2(v0[0], v0[1]), pk2(v0[2], v0[3]), pk2(v1[0], v1[1]), pk2(v1[2], v1[3])};
                    if (nt) __builtin_nontemporal_store(w, (v4u*)(O + (size_t)r * ldc + col0 + bj * 128)); else *(v4u*)(O + (size_t)r * ldc + col0 + bj * 128) = w;
                }
            }
    }
};
struct EpiResNorm {
    static constexpr bool PERM = false, AFTER_DRAIN = true;
    const bf16* base; float* out; const float* gain; float alpha; float* part; unsigned* cnt;
    __device__ __forceinline__ void fused(pg8::f32x4 (&acc)[2][2][4][2], const pg8::Unit& u, int wr, int wc, int fr, int fq, PG8_LAS unsigned char* lds, int wid, int lane) const {
        const int row0 = u.pm * 256 + wr * 64 + fr, col0 = u.pn * 256 + wc * 32 + 4 * fq;
        LAS float* P = (LAS float*)lds;
        LAS float* S = (LAS float*)(lds + 4096);
#pragma unroll
        for (int ai = 0; ai < 2; ++ai) {
            v2u bw[4][2][2];
#pragma unroll
            for (int m = 0; m < 4; ++m)
#pragma unroll
                for (int bj = 0; bj < 2; ++bj)
#pragma unroll
                    for (int n = 0; n < 2; ++n) bw[m][bj][n] = *(const v2u*)(base + (size_t)(row0 + ai * 128 + m * 16) * DM + col0 + bj * 128 + n * 16);
#pragma unroll
            for (int m = 0; m < 4; ++m) {
                float ss = 0.f;
#pragma unroll
                for (int bj = 0; bj < 2; ++bj)
#pragma unroll
                    for (int n = 0; n < 2; ++n) {
                        const v2u w = bw[m][bj][n];
                        const f32x4 bs = {bflo(w.x), bfhi(w.x), bflo(w.y), bfhi(w.y)};
                        const f32x4 v = bs + acc[ai][bj][m][n] * alpha;
                        acc[ai][bj][m][n] = v;
                        ss += (v[0] * v[0] + v[1] * v[1]) + (v[2] * v[2] + v[3] * v[3]);
                    }
                ss += __shfl_xor(ss, 16); ss += __shfl_xor(ss, 32);
                if (fq == 0) P[(ai * 128 + wr * 64 + m * 16 + fr) * 4 + wc] = ss;
            }
        }
        __syncthreads();
        const int tid = wid * 64 + lane;
        if (tid < 256) {
            const float t = (P[tid * 4] + P[tid * 4 + 1]) + (P[tid * 4 + 2] + P[tid * 4 + 3]);
            __hip_atomic_store(part + (size_t)(u.pm * 256 + tid) * 4 + u.pn, t, __ATOMIC_RELAXED, __HIP_MEMORY_SCOPE_AGENT);
        }
        asm volatile("s_waitcnt vmcnt(0)" ::: "memory");
        __syncthreads();
        if (tid == 0) {
            __hip_atomic_fetch_add(cnt + 64 * u.pm, 1u, __ATOMIC_RELEASE, __HIP_MEMORY_SCOPE_AGENT);
            unsigned sp = 0;
            while (__hip_atomic_load(cnt + 64 * u.pm, __ATOMIC_RELAXED, __HIP_MEMORY_SCOPE_AGENT) < 4u && ++sp < (1u << 22)) __builtin_amdgcn_s_sleep(2);
            __builtin_amdgcn_fence(__ATOMIC_ACQUIRE, "agent");
        }
        __syncthreads();
        if (tid < 256) {
            const float* pp = part + (size_t)(u.pm * 256 + tid) * 4;
            const float t = (__hip_atomic_load(pp, __ATOMIC_RELAXED, __HIP_MEMORY_SCOPE_AGENT) + __hip_atomic_load(pp + 1, __ATOMIC_RELAXED, __HIP_MEMORY_SCOPE_AGENT))
                          + (__hip_atomic_load(pp + 2, __ATOMIC_RELAXED, __HIP_MEMORY_SCOPE_AGENT) + __hip_atomic_load(pp + 3, __ATOMIC_RELAXED, __HIP_MEMORY_SCOPE_AGENT));
            S[tid] = rsqrtf(t * (1.f / DM) + EPS);
        }
        __syncthreads();
        f32x4 gv[2][2];
#pragma unroll
        for (int bj = 0; bj < 2; ++bj)
#pragma unroll
            for (int n = 0; n < 2; ++n) gv[bj][n] = *(const f32x4*)(gain + col0 + bj * 128 + n * 16);
#pragma unroll
        for (int ai = 0; ai < 2; ++ai)
#pragma unroll
            for (int m = 0; m < 4; ++m) {
                const int rl = ai * 128 + wr * 64 + m * 16 + fr; const float rs = S[rl]; const size_t off = (size_t)(u.pm * 256 + rl) * DM + col0;
#pragma unroll
                for (int bj = 0; bj < 2; ++bj)
#pragma unroll
                    for (int n = 0; n < 2; ++n) { f32x4 ov = acc[ai][bj][m][n] * rs * gv[bj][n];
                        *(f32x4*)(out + off + bj * 128 + n * 16) = ov; }
            }
    }
};
struct OrderUpKV {
    pg8::StaticOrder base; int extra;
    __device__ bool next(int i, pg8::Unit& u) const {
        long L = (long)i * base.G + base.c;
        if (L < base.nwg) return base.next(i, u);
        L -= base.nwg; if (L >= extra) return false;
        u.pm = MTOK / 256 + (int)(L / 8); u.pn = base.nN + (int)(L % 8); return true;
    }
    __device__ __forceinline__ void a_ready(const pg8::Unit&) const {}
    __device__ __forceinline__ void done(const pg8::Unit&) const {}
};

template <int NW>
__device__ __forceinline__ void tr_tile(const float* __restrict__ W, int N, int K, int k0, int n0, bf16* orow0, LAS float* scr, int lane, const float* gain = nullptr) {
    constexpr int LPR = NW / 4, RPI = 64 / LPR, NI = 64 / RPI, STR = NW + 1, NO = NW * 8 / 64;
    const int kr = lane / LPR, nc = (lane % LPR) * 4;
    f32x4 v[NI];
#pragma unroll
    for (int i = 0; i < NI; ++i) v[i] = __builtin_nontemporal_load((const f32x4*)(W + (size_t)(k0 + i * RPI + kr) * N + n0 + nc));
    if (gain) {
#pragma unroll
        for (int i = 0; i < NI; ++i) v[i] = v[i] * gain[k0 + i * RPI + kr];
    }
#pragma unroll
    for (int i = 0; i < NI; ++i) { LAS float* d = scr + (i * RPI + kr) * STR + nc; d[0] = v[i][0]; d[1] = v[i][1]; d[2] = v[i][2]; d[3] = v[i][3]; }
    LDS_WAIT();
#pragma unroll
    for (int j = 0; j < NO; ++j) {
        const int idx = j * 64 + lane, c = idx & 7, n = idx >> 3; const LAS float* sp = scr + (8 * c) * STR + n;
        v4u o; o.x = pk2(sp[0 * STR], sp[1 * STR]); o.y = pk2(sp[2 * STR], sp[3 * STR]); o.z = pk2(sp[4 * STR], sp[5 * STR]); o.w = pk2(sp[6 * STR], sp[7 * STR]);
        *(v4u*)(orow0 + (size_t)n * K + k0 + 8 * c) = o;
    }
    LDS_WAIT();
}
__device__ __forceinline__ void norm_rows2_bf16(const float* x0, const float* x1, const float* gain, bf16* o0, bf16* o1, int lane) {
    const f32x4* xr0 = (const f32x4*)x0 + lane; const f32x4* xr1 = (const f32x4*)x1 + lane; const f32x4* gr = (const f32x4*)gain + lane;
    f32x4 v0[4], v1[4]; float s0 = 0.f, s1 = 0.f;
#pragma unroll
    for (int j = 0; j < 4; ++j) { v0[j] = __builtin_nontemporal_load(xr0 + 64 * j); v1[j] = __builtin_nontemporal_load(xr1 + 64 * j); }
#pragma unroll
    for (int j = 0; j < 4; ++j) { s0 += (v0[j][0] * v0[j][0] + v0[j][1] * v0[j][1]) + (v0[j][2] * v0[j][2] + v0[j][3] * v0[j][3]); s1 += (v1[j][0] * v1[j][0] + v1[j][1] * v1[j][1]) + (v1[j][2] * v1[j][2] + v1[j][3] * v1[j][3]); }
    const float r0 = rsqrtf(wave_sum(s0) * (1.f / DM) + EPS), r1 = rsqrtf(wave_sum(s1) * (1.f / DM) + EPS);
    v2u* p0 = (v2u*)o0 + lane; v2u* p1 = (v2u*)o1 + lane;
#pragma unroll
    for (int j = 0; j < 4; ++j) { const f32x4 gg = gr[64 * j]; const f32x4 t0 = v0[j] * r0 * gg, t1 = v1[j] * r1 * gg;
        p0[64 * j] = (v2u){pk2(t0[0], t0[1]), pk2(t0[2], t0[3])}; p1[64 * j] = (v2u){pk2(t1[0], t1[1]), pk2(t1[2], t1[3])}; }
}

constexpr int GL_STR = 72;
constexpr int GL_A0 = 0, GL_A1 = 9216, GL_A2 = 18432, GL_A3 = 27648, GL_VT = 36864, GL_SS = 36864 + 18432;

struct GlaIn { unsigned short qr[4][4], kr[4][4]; float bw[4]; float bias; f32x4 zv[4]; v4u vraw[2]; };
__device__ __forceinline__ void gla_front_load(GlaIn& R, const float* z, const bf16* proj, const float* gfw, const float* gfb, const float* gbw, const float* gbb,
                                               int b, int h, int n, int tid, int wave, int lane) {
    const int fr = lane & 15, fq = lane >> 4, jt = wave & 3, dir = wave >> 2;
    const int T0 = b * SEQ + n * 64, col = h * 64 + jt * 16 + fr;
    const float* gw = dir ? gbw : gfw; const float* gbias = dir ? gbb : gfb;
#pragma unroll
    for (int tt = 0; tt < 4; ++tt)
#pragma unroll
        for (int i = 0; i < 4; ++i) { const bf16* pr = proj + (size_t)(T0 + tt * 16 + fq * 4 + i) * NPROJ + col; R.qr[tt][i] = pr[0]; R.kr[tt][i] = pr[256]; }
#pragma unroll
    for (int ks = 0; ks < 4; ++ks) R.bw[ks] = gw[(fq * 4 + ks) * 256 + col];
    R.bias = gbias[col];
#pragma unroll
    for (int tt = 0; tt < 4; ++tt) R.zv[tt] = *(const f32x4*)(z + (size_t)(T0 + tt * 16 + fr) * 32 + dir * 16 + fq * 4);
#pragma unroll
    for (int i = 0; i < 2; ++i) { const int cc = tid + 512 * i; R.vraw[i] = *(const v4u*)(proj + (size_t)(T0 + (cc & 63)) * NPROJ + 512 + h * 128 + (cc >> 6) * 8); }
}
template <bool G1>
__device__ __forceinline__ void gla_front_compute(const GlaIn& R, LAS unsigned char* lds, float* decay, int b, int h, int n, int tid, int wave, int lane) {
    const int fr = lane & 15, fq = lane >> 4, jt = wave & 3, dir = wave >> 2, bh = b * 4 + h;
    float g[4][4], c[4][4];
#pragma unroll
    for (int tt = 0; tt < 4; ++tt) {
        f32x4 a = {R.bias, R.bias, R.bias, R.bias};
#pragma unroll
        for (int ks = 0; ks < 4; ++ks) a = __builtin_amdgcn_mfma_f32_16x16x4f32(R.zv[tt][ks], R.bw[ks], a, 0, 0, 0);
#pragma unroll
        for (int i = 0; i < 4; ++i) g[tt][i] = logsig_f(a[i]) * (1.f / 16.f);
    }
    float base = 0.f;
#pragma unroll
    for (int tt = 0; tt < 4; ++tt) {
        const float p0 = g[tt][0], p1 = p0 + g[tt][1], p2 = p1 + g[tt][2], p3 = p2 + g[tt][3];
        const float x1 = __shfl_up(p3, 16), x2 = __shfl_up(p3, 32), x3 = __shfl_up(p3, 48);
        const float excl = (fq >= 1 ? x1 : 0.f) + (fq >= 2 ? x2 : 0.f) + (fq >= 3 ? x3 : 0.f);
        const float ttot = __shfl(excl + p3, 48 + fr);
        const float off = base + excl;
        c[tt][0] = off + p0; c[tt][1] = off + p1; c[tt][2] = off + p2; c[tt][3] = off + p3;
        base += ttot;
    }
    const float total = base;
    if (dir) {
#pragma unroll
        for (int tt = 0; tt < 4; ++tt)
#pragma unroll
            for (int i = 0; i < 4; ++i) c[tt][i] = total - c[tt][i] + g[tt][i];
    }
    if (G1) {
        LAS bf16* KS = (LAS bf16*)(lds + (dir ? GL_A1 : GL_A0));
#pragma unroll
        for (int tt = 0; tt < 4; ++tt) {
            float e[4];
#pragma unroll
            for (int i = 0; i < 4; ++i) e[i] = __uint_as_float((unsigned)R.kr[tt][i] << 16) * __expf(total - c[tt][i]);
            *(LAS v2u*)(KS + (jt * 16 + fr) * GL_STR + tt * 16 + fq * 4) = (v2u){pk2(e[0], e[1]), pk2(e[2], e[3])};
        }
        if (fq == 0) decay[((size_t)(dir * 8 + bh) * 128 + n) * 64 + jt * 16 + fr] = __expf(total);
    } else {
        LAS bf16* Qd = (LAS bf16*)(lds + (dir ? GL_A2 : GL_A0)); LAS bf16* Kd = (LAS bf16*)(lds + (dir ? GL_A3 : GL_A1));
#pragma unroll
        for (int tt = 0; tt < 4; ++tt)
#pragma unroll
            for (int i = 0; i < 4; ++i) {
                const int t = tt * 16 + fq * 4 + i;
                const float q = __uint_as_float((unsigned)R.qr[tt][i] << 16) * 0.125f, k = __uint_as_float((unsigned)R.kr[tt][i] << 16);
                const unsigned w = pk2(q * __expf(c[tt][i]), k * __expf(-c[tt][i]));
                Qd[t * GL_STR + jt * 16 + fr] = (bf16)(w & 0xffffu); Kd[t * GL_STR + jt * 16 + fr] = (bf16)(w >> 16);
            }
    }
    LAS bf16* VTl = (LAS bf16*)(lds + GL_VT);
#pragma unroll
    for (int j = 0; j < 2; ++j) {
        const int cc = tid + 512 * j, t = cc & 63, dvc = cc >> 6;
        const v4u raw = R.vraw[j];
        LAS bf16* dst = VTl + (dvc * 8) * GL_STR + t;
#pragma unroll
        for (int i = 0; i < 8; ++i) dst[i * GL_STR] = (bf16)((i & 1) ? (raw[i >> 1] >> 16) : (raw[i >> 1] & 0xffffu));
    }
}

__device__ __forceinline__ void gla_g1(LAS unsigned char* lds, const float* z, const bf16* proj, const float* gfw, const float* gfb, const float* gbw, const float* gbb,
                                       float* decay, bf16* ST, const float* conv_w, const float* conv_b, bf16* mix, int G, int bid, int tid, int wave, int lane) {
    const int fr = lane & 15, fq = lane >> 4;
    GlaIn R;
    if (bid < 1024) gla_front_load(R, z, proj, gfw, gfb, gbw, gbb, (bid >> 7) >> 2, (bid >> 7) & 3, bid & 127, tid, wave, lane);
    for (int it = bid; it < 1024; it += G) {
        const int bh = it >> 7, n = it & 127, b = bh >> 2, h = bh & 3;
        const int cc0 = h * 128 + (tid & 15) * 8;
        v4u cbg[2], ccg[2][3], cxv[2][3];
#pragma unroll
        for (int i = 0; i < 2; ++i) {
            const int t = b * SEQ + n * 64 + (tid >> 4) + 32 * i;
            const bf16* row = proj + (size_t)t * NPROJ;
            cbg[i] = *(const v4u*)(row + 1536 + cc0); ccg[i][1] = *(const v4u*)(row + 2048 + cc0); cxv[i][1] = *(const v4u*)(row + 2560 + cc0);
            const bool hp = (t & (SEQ - 1)) != 0, hn = (t & (SEQ - 1)) != SEQ - 1;
            ccg[i][0] = (v4u){0, 0, 0, 0}; cxv[i][0] = (v4u){0, 0, 0, 0}; ccg[i][2] = (v4u){0, 0, 0, 0}; cxv[i][2] = (v4u){0, 0, 0, 0};
            if (hp) { ccg[i][0] = *(const v4u*)(row - NPROJ + 2048 + cc0); cxv[i][0] = *(const v4u*)(row - NPROJ + 2560 + cc0); }
            if (hn) { ccg[i][2] = *(const v4u*)(row + NPROJ + 2048 + cc0); cxv[i][2] = *(const v4u*)(row + NPROJ + 2560 + cc0); }
        }
        gla_front_compute<true>(R, lds, decay, b, h, n, tid, wave, lane);
        { const int nx = it + G; if (nx < 1024) gla_front_load(R, z, proj, gfw, gfb, gbw, gbb, (nx >> 7) >> 2, (nx >> 7) & 3, nx & 127, tid, wave, lane); }
        {
            f32x4 w0[2], w1[2], w2[2], cb[2];
#pragma unroll
            for (int q = 0; q < 2; ++q) { w0[q] = *(const f32x4*)(conv_w + cc0 + 4 * q); w1[q] = *(const f32x4*)(conv_w + 512 + cc0 + 4 * q); w2[q] = *(const f32x4*)(conv_w + 1024 + cc0 + 4 * q); cb[q] = *(const f32x4*)(conv_b + cc0 + 4 * q); }
#pragma unroll
            for (int i = 0; i < 2; ++i) {
                const int t = b * SEQ + n * 64 + (tid >> 4) + 32 * i;
                float o[8];
#pragma unroll
                for (int e = 0; e < 8; ++e) {
                    const int w = e >> 1; const bool hi = e & 1;
                    const float up = (hi ? bfhi(ccg[i][0][w]) : bflo(ccg[i][0][w])) * (hi ? bfhi(cxv[i][0][w]) : bflo(cxv[i][0][w]));
                    const float uc = (hi ? bfhi(ccg[i][1][w]) : bflo(ccg[i][1][w])) * (hi ? bfhi(cxv[i][1][w]) : bflo(cxv[i][1][w]));
                    const float un = (hi ? bfhi(ccg[i][2][w]) : bflo(ccg[i][2][w])) * (hi ? bfhi(cxv[i][2][w]) : bflo(cxv[i][2][w]));
                    const float g = hi ? bfhi(cbg[i][w]) : bflo(cbg[i][w]);
                    o[e] = g * (w0[e >> 2][e & 3] * up + w1[e >> 2][e & 3] * uc + w2[e >> 2][e & 3] * un + cb[e >> 2][e & 3]);
                }
                *(v4u*)(mix + (size_t)t * DM + 512 + cc0) = (v4u){pk2(o[0], o[1]), pk2(o[2], o[3]), pk2(o[4], o[5]), pk2(o[6], o[7])};
            }
        }
        __syncthreads();
        const LAS bf16* VTl = (const LAS bf16*)(lds + GL_VT);
        bf16x8 vb[2];
#pragma unroll
        for (int ks = 0; ks < 2; ++ks) vb[ks] = *(const LAS bf16x8*)(VTl + (wave * 16 + fr) * GL_STR + ks * 32 + fq * 8);
#pragma unroll
        for (int dir = 0; dir < 2; ++dir) {
            const LAS bf16* KS = (const LAS bf16*)(lds + (dir ? GL_A1 : GL_A0));
#pragma unroll
            for (int nt = 0; nt < 4; ++nt) {
                f32x4 acc = {0.f, 0.f, 0.f, 0.f};
#pragma unroll
                for (int ks = 0; ks < 2; ++ks) { const bf16x8 ka = *(const LAS bf16x8*)(KS + (nt * 16 + fr) * GL_STR + ks * 32 + fq * 8); acc = MFMA16(ka, vb[ks], acc); }
                *(v2u*)(ST + ((size_t)(dir * 8 + bh) * 128 + n) * 8192 + (wave * 16 + fr) * 64 + nt * 16 + fq * 4) = (v2u){pk2(acc[0], acc[1]), pk2(acc[2], acc[3])};
            }
        }
        __syncthreads();
    }
}

__device__ __forceinline__ void gla_g2(bf16* ST, const float* decay, int G, int bid, int tid) {
    for (int e = bid * 512 + tid; e < 16 * 8192; e += G * 512) {
        const int chain = e >> 13, el = e & 8191, j = el & 63, dir = chain >> 3;
        bf16* base = ST + (size_t)chain * 128 * 8192 + el; const float* dec = decay + (size_t)chain * 128 * 64 + j;
        float S = 0.f;
        for (int s0 = 0; s0 < 128; s0 += 64) {
            float tmp[64], d[64];
#pragma unroll
            for (int u = 0; u < 64; ++u) { const int n = dir ? 127 - (s0 + u) : s0 + u; tmp[u] = __uint_as_float((unsigned)base[(size_t)n * 8192] << 16); d[u] = dec[n * 64]; }
#pragma unroll
            for (int u = 0; u < 64; ++u) { const int n = dir ? 127 - (s0 + u) : s0 + u; base[(size_t)n * 8192] = (bf16)(pk2(S, 0.f) & 0xffffu); S = d[u] * S + tmp[u]; }
        }
    }
}

__device__ __forceinline__ void gla_g3(LAS unsigned char* lds, const float* z, const bf16* proj, const float* gfw, const float* gfb, const float* gbw, const float* gbb,
                                       const bf16* ST, const float* gla_norm, bf16* mix, int G, int bid, int tid, int wave, int lane) {
    const int fr = lane & 15, fq = lane >> 4, tt = wave & 3, dh = wave >> 2;
    GlaIn R;
    if (bid < 1024) gla_front_load(R, z, proj, gfw, gfb, gbw, gbb, (bid >> 7) >> 2, (bid >> 7) & 3, bid & 127, tid, wave, lane);
    for (int it = bid; it < 1024; it += G) {
        const int bh = it >> 7, n = it & 127, b = bh >> 2, h = bh & 3;
        bf16x8 stf[2][4][2]; v2u rr4[4];
#pragma unroll
        for (int dir = 0; dir < 2; ++dir)
#pragma unroll
            for (int dt = 0; dt < 4; ++dt)
#pragma unroll
                for (int ks = 0; ks < 2; ++ks) stf[dir][dt][ks] = *(const bf16x8*)(ST + ((size_t)(dir * 8 + bh) * 128 + n) * 8192 + (size_t)((dh * 4 + dt) * 16 + fr) * 64 + ks * 32 + fq * 8);
#pragma unroll
        for (int dt = 0; dt < 4; ++dt) rr4[dt] = *(const v2u*)(proj + (size_t)(b * SEQ + n * 64 + tt * 16 + fr) * NPROJ + 1024 + h * 128 + (dh * 4 + dt) * 16 + fq * 4);
        gla_front_compute<false>(R, lds, nullptr, b, h, n, tid, wave, lane);
        __syncthreads();
        { const int nx = it + G; if (nx < 1024) gla_front_load(R, z, proj, gfw, gfb, gbw, gbb, (nx >> 7) >> 2, (nx >> 7) & 3, nx & 127, tid, wave, lane); }
        const LAS bf16* VTl = (const LAS bf16*)(lds + GL_VT);
        f32x4 o[4];
#pragma unroll
        for (int dt = 0; dt < 4; ++dt) o[dt] = (f32x4){0.f, 0.f, 0.f, 0.f};
#pragma unroll
        for (int dir = 0; dir < 2; ++dir) {
            const LAS bf16* Qd = (const LAS bf16*)(lds + (dir ? GL_A2 : GL_A0));
            const LAS bf16* Kd = (const LAS bf16*)(lds + (dir ? GL_A3 : GL_A1));
            bf16x8 qfr[2];
#pragma unroll
            for (int ks = 0; ks < 2; ++ks) qfr[ks] = *(const LAS bf16x8*)(Qd + (tt * 16 + fr) * GL_STR + ks * 32 + fq * 8);
            f32x4 at[4];
#pragma unroll
            for (int mt = 0; mt < 4; ++mt) {
                f32x4 a = {0.f, 0.f, 0.f, 0.f};
                const bool live = dir ? (mt >= tt) : (mt <= tt);
                if (live) {
#pragma unroll
                    for (int ks = 0; ks < 2; ++ks) { const bf16x8 kfr = *(const LAS bf16x8*)(Kd + (mt * 16 + fr) * GL_STR + ks * 32 + fq * 8); a = MFMA16(kfr, qfr[ks], a); }
                    if (mt == tt) {
#pragma unroll
                        for (int i = 0; i < 4; ++i) { const int m = fq * 4 + i; const bool keep = dir ? (m >= fr) : (m <= fr); a[i] = keep ? a[i] : 0.f; }
                    }
                }
                at[mt] = a;
            }
            bf16x8 pa[2];
#pragma unroll
            for (int s2 = 0; s2 < 2; ++s2) pa[s2] = mk8(pk2(at[2 * s2][0], at[2 * s2][1]), pk2(at[2 * s2][2], at[2 * s2][3]), pk2(at[2 * s2 + 1][0], at[2 * s2 + 1][1]), pk2(at[2 * s2 + 1][2], at[2 * s2 + 1][3]));
#pragma unroll
            for (int dt = 0; dt < 4; ++dt) {
                const int dvrow = (dh * 4 + dt) * 16 + fr;
#pragma unroll
                for (int s2 = 0; s2 < 2; ++s2) {
                    const v2u lo = *(const LAS v2u*)(VTl + dvrow * GL_STR + s2 * 32 + fq * 4), hi = *(const LAS v2u*)(VTl + dvrow * GL_STR + s2 * 32 + 16 + fq * 4);
                    o[dt] = MFMA16(mk8(lo.x, lo.y, hi.x, hi.y), pa[s2], o[dt]);
                }
#pragma unroll
                for (int ks = 0; ks < 2; ++ks) {
                    o[dt] = MFMA16(stf[dir][dt][ks], qfr[ks], o[dt]);
                }
            }
        }
        float ss = 0.f;
#pragma unroll
        for (int dt = 0; dt < 4; ++dt) ss += (o[dt][0] * o[dt][0] + o[dt][1] * o[dt][1]) + (o[dt][2] * o[dt][2] + o[dt][3] * o[dt][3]);
        ss += __shfl_xor(ss, 16); ss += __shfl_xor(ss, 32);
        LAS float* SS = (LAS float*)(lds + GL_SS);
        if (fq == 0) SS[dh * 64 + tt * 16 + fr] = ss;
        __syncthreads();
        const float tot = SS[tt * 16 + fr] + SS[64 + tt * 16 + fr];
        const float rs = rsqrtf(tot * (1.f / 128.f) + EPS);
        const int tok = b * SEQ + n * 64 + tt * 16 + fr;
#pragma unroll
        for (int dt = 0; dt < 4; ++dt) {
            const int c = h * 128 + (dh * 4 + dt) * 16 + fq * 4;
            const v2u rr = rr4[dt];
            const f32x4 gn = *(const f32x4*)(gla_norm + c);
            const float v0 = o[dt][0] * rs * gn[0] * silu_f(bflo(rr.x)), v1 = o[dt][1] * rs * gn[1] * silu_f(bfhi(rr.x));
            const float v2 = o[dt][2] * rs * gn[2] * silu_f(bflo(rr.y)), v3 = o[dt][3] * rs * gn[3] * silu_f(bfhi(rr.y));
            *(v2u*)(mix + (size_t)tok * DM + c) = (v2u){pk2(v0, v1), pk2(v2, v3)};
        }
    }
}

typedef float f32x16 __attribute__((ext_vector_type(16)));
#define MFMA32(a, b, c) __builtin_amdgcn_mfma_f32_32x32x16_bf16((a), (b), (c), 0, 0, 0)
template <int RS>
__device__ __forceinline__ void xattn_stage(LAS unsigned char* lds, const bf16* src, int tid) {
    const unsigned char* g = (const unsigned char*)src + (size_t)tid * 16;
    LAS unsigned char* wb = lds + (tid >> 5) * RS + (tid & 31) * 16;
#pragma unroll
    for (int hb = 0; hb < 2; ++hb) {
        v4u r[8];
#pragma unroll
        for (int i = 0; i < 8; ++i) r[i] = *(const v4u*)(g + (hb * 8 + i) * 8192);
#pragma unroll
        for (int i = 0; i < 8; ++i) *(LAS v4u*)(wb + (hb * 8 + i) * 16 * RS) = r[i];
        asm volatile("" ::: "memory");
    }
}
__device__ __forceinline__ void xattn_unit(LAS unsigned char* lds, const bf16* QO, bf16* OO, const bf16* Kmem, const bf16* VT, int bh, int qt, int tid, int wave, int lane) {
    const int l31 = lane & 31, hh = lane >> 5, b = bh >> 2, h = bh & 3;
    const int row = b * SEQ + qt * 256 + wave * 32 + l31;
    xattn_stage<528>(lds, Kmem + (size_t)bh * 65536, tid);
    bf16x8 qf[16];
#pragma unroll
    for (int ks = 0; ks < 16; ++ks) qf[ks] = *(const bf16x8*)(QO + (size_t)row * DM + h * 256 + ks * 16 + hh * 8);
    __syncthreads();
    f32x16 st[8];
#pragma unroll
    for (int kt = 0; kt < 8; ++kt) {
        f32x16 a;
#pragma unroll
        for (int i = 0; i < 16; ++i) a[i] = 0.f;
        const LAS unsigned char* kp = lds + (kt * 32 + l31) * 528 + hh * 16;
        __builtin_amdgcn_s_setprio(1);
#pragma unroll
        for (int ks = 0; ks < 16; ++ks) a = MFMA32(*(const LAS bf16x8*)(kp + ks * 32), qf[ks], a);
        __builtin_amdgcn_s_setprio(0);
        st[kt] = a;
        asm volatile("" ::: "memory");
    }
    float mx = -3.0e38f;
#pragma unroll
    for (int kt = 0; kt < 8; ++kt)
#pragma unroll
        for (int i = 0; i < 16; ++i) mx = fmaxf(mx, st[kt][i]);
    mx = fmaxf(mx, __shfl_xor(mx, 32));
    float l = 0.f;
    bf16x8 pb[8][2];
#pragma unroll
    for (int kt = 0; kt < 8; ++kt)
#pragma unroll
        for (int s2 = 0; s2 < 2; ++s2) {
            float pv[8];
#pragma unroll
            for (int j = 0; j < 8; ++j) { pv[j] = __builtin_amdgcn_exp2f(st[kt][8 * s2 + j] - mx); l += pv[j]; }
            pb[kt][s2] = mk8(pk2(pv[0], pv[1]), pk2(pv[2], pv[3]), pk2(pv[4], pv[5]), pk2(pv[6], pv[7]));
        }
    l += __shfl_xor(l, 32);
    const float inv = 1.f / l;
    __syncthreads();
    xattn_stage<520>(lds, VT + (size_t)bh * 65536, tid);
    __syncthreads();
    bf16* orow = OO + (size_t)row * DM + h * 256;
#pragma unroll 1
    for (int dt = 0; dt < 8; ++dt) {
        f32x16 a;
#pragma unroll
        for (int i = 0; i < 16; ++i) a[i] = 0.f;
        const LAS unsigned char* vp = lds + (dt * 32 + l31) * 520 + hh * 8;
        __builtin_amdgcn_s_setprio(1);
#pragma unroll
        for (int kt = 0; kt < 8; ++kt)
#pragma unroll
            for (int s2 = 0; s2 < 2; ++s2) {
                const v2u lo = *(const LAS v2u*)(vp + (kt * 32 + 16 * s2) * 2), hi = *(const LAS v2u*)(vp + (kt * 32 + 16 * s2 + 8) * 2);
                a = MFMA32(mk8(lo.x, lo.y, hi.x, hi.y), pb[kt][s2], a);
            }
        __builtin_amdgcn_s_setprio(0);
        unsigned w[4][2];
#pragma unroll
        for (int g = 0; g < 4; ++g) { w[g][0] = pk2(a[4 * g] * inv, a[4 * g + 1] * inv); w[g][1] = pk2(a[4 * g + 2] * inv, a[4 * g + 3] * inv); }
#pragma unroll
        for (int k = 0; k < 4; k += 2) {
            const auto r0 = __builtin_amdgcn_permlane32_swap(w[k][0], w[k + 1][0], false, false);
            const auto r1 = __builtin_amdgcn_permlane32_swap(w[k][1], w[k + 1][1], false, false);
            *(v4u*)(orow + dt * 32 + 8 * k + 8 * hh) = (v4u){(unsigned)r0[0], (unsigned)r1[0], (unsigned)r0[1], (unsigned)r1[1]};
        }
    }
    __syncthreads();
}
__device__ __forceinline__ void xattn_phase(LAS unsigned char* lds, const bf16* QO, bf16* OO, const bf16* Kmem, const bf16* VT, int G, int bid, int tid, int wave, int lane) {
    for (int u = bid; u < 256; u += G) xattn_unit(lds, QO, OO, Kmem, VT, u >> 5, u & 31, tid, wave, lane);
}

#define RLX_AGENT __ATOMIC_RELAXED, __HIP_MEMORY_SCOPE_AGENT
#define XB_TMO      128
#define XB_XCNT(j)  (256  + 64 * (j))
#define XB_XSUB(j)  (1280 + 64 * (j))
#define XB_XGEN(j)  (2304 + 64 * (j))
#define XB_TOP      3328
#define XB_TOPGEN   3392
#define XCD_BAR_WORDS 3456
#define XB_SPIN_CAP (1u << 18)

__device__ __forceinline__ unsigned xb_ld(unsigned* p)              { return __hip_atomic_load(p, __ATOMIC_RELAXED, __HIP_MEMORY_SCOPE_AGENT); }
__device__ __forceinline__ unsigned xb_add(unsigned* p, unsigned v) { return __hip_atomic_fetch_add(p, v, __ATOMIC_RELAXED, __HIP_MEMORY_SCOPE_AGENT); }
__device__ __forceinline__ unsigned xb_xcc_id() { return (unsigned)__builtin_amdgcn_s_getreg((3 << 11) | 20) & 0xFu; }
#define XB_SPIN(cond, bar) do { unsigned _sp = 0; while (cond) { __builtin_amdgcn_s_sleep(1); \
    if ((++_sp & 255u) == 0u) { if (xb_ld(&(bar)[XB_TMO])) break; if (_sp > XB_SPIN_CAP) { atomicAdd(&(bar)[XB_TMO], 1u); break; } } } } while (0)

struct XcdBarrier {
    unsigned* bar; unsigned x;
    volatile LAS unsigned* st;
};

__device__ __forceinline__ XcdBarrier xcd_barrier_post(unsigned* bar, volatile LAS unsigned* st) {
    XcdBarrier b; b.bar = bar; b.x = xb_xcc_id(); b.st = st;
    if (threadIdx.x == 0) (void)xb_add(&bar[XB_XCNT(b.x)], 1u);
    return b;
}
__device__ __forceinline__ void xcd_barrier_complete(unsigned* bar, unsigned x, unsigned& nloc, unsigned& nx) {
    const unsigned G = gridDim.x * gridDim.y * gridDim.z;
    unsigned sum, cnt, mine, sp = 0u;
    for (;;) {
        sum = 0u; cnt = 0u; mine = 0u;
#pragma unroll
        for (unsigned j = 0; j < 16; ++j) { const unsigned c = xb_ld(&bar[XB_XCNT(j)]); sum += c; cnt += (c > 0u) ? 1u : 0u; mine = (j == x) ? c : mine; }
        if (sum == G) break;
        __builtin_amdgcn_s_sleep(1);
        if ((++sp & 255u) == 0u) { if (xb_ld(&bar[XB_TMO])) break; if (sp > XB_SPIN_CAP) { atomicAdd(&bar[XB_TMO], 1u); break; } }
    }
    nloc = mine > 0u ? mine : 1u; nx = cnt > 0u ? cnt : 1u;
}

__device__ __forceinline__ void xcd_barrier(const XcdBarrier& b) {
    asm volatile("s_waitcnt vmcnt(0)" ::: "memory");
    __syncthreads();
    if (threadIdx.x == 0) {
        unsigned* bar = b.bar;
        __builtin_amdgcn_s_waitcnt(0);
        unsigned nloc = b.st[0], nx = b.st[1];
        if (nloc == 0u) { xcd_barrier_complete(bar, b.x, nloc, nx); b.st[0] = nloc; b.st[1] = nx; }
        const unsigned old = xb_add(&bar[XB_XSUB(b.x)], 1u);
        const unsigned gen = old / nloc;
        if (old + 1u == (gen + 1u) * nloc) {
            __builtin_amdgcn_fence(__ATOMIC_RELEASE, "agent");
            asm volatile("s_waitcnt vmcnt(0)" ::: "memory");
            const unsigned og = xb_add(&bar[XB_TOP], 1u);
            const unsigned tg = og / nx;
            if (og + 1u == (tg + 1u) * nx) xb_add(&bar[XB_TOPGEN], 1u);
            else XB_SPIN(xb_ld(&bar[XB_TOPGEN]) == tg, bar);
            __builtin_amdgcn_fence(__ATOMIC_ACQUIRE, "agent");
            xb_add(&bar[XB_XGEN(b.x)], 1u);
            asm volatile("s_waitcnt vmcnt(0)" ::: "memory");
        } else {
            XB_SPIN(xb_ld(&bar[XB_TOPGEN]) == gen, bar);
            __builtin_amdgcn_fence(__ATOMIC_ACQUIRE, "agent");
            asm volatile("s_waitcnt vmcnt(0)" ::: "memory");
        }
    }
    __syncthreads();
}

constexpr int I_UP = 16 * 44, I_KV = 16 * 32, I_DN = 44 * 16, I_IN = 16 * 97, I_SQ = 16 * 16;
constexpr int N_EARLY = 2 * I_UP + I_KV, N_LATE = I_DN + I_IN + 3 * I_SQ + 2 * I_UP + I_DN;
struct Params { const float* in[26]; float* out; unsigned char* ws; };


__global__ void __launch_bounds__(512) fwd_kernel(Params p) {
    extern __shared__ __attribute__((aligned(16))) unsigned char lds_raw[];
    LAS unsigned char* lds = (LAS unsigned char*)lds_raw;
#define FRESH_TID() int tid = threadIdx.x; asm volatile("" : "+v"(tid)); const int lane = tid & 63, wave = __builtin_amdgcn_readfirstlane(tid >> 6); (void)lane; (void)wave
    const int G = gridDim.x, bid = blockIdx.x;
    unsigned char* ws = p.ws;
    float* rowss = (float*)(ws + WS_ROWSS); float* zbuf = (float*)(ws + WS_Z); float* decay = (float*)(ws + WS_DECAY);
    bf16* W1CAT = (bf16*)(ws + WS_W1CAT); bf16* WD1 = (bf16*)(ws + WS_WD1); bf16* WIN = (bf16*)(ws + WS_WIN); bf16* WZ = (bf16*)(ws + WS_WZ);
    bf16* WOUT = (bf16*)(ws + WS_WOUT); bf16* WQ = (bf16*)(ws + WS_WQ); bf16* WO = (bf16*)(ws + WS_WO); bf16* W2CAT = (bf16*)(ws + WS_W2CAT); bf16* WD2 = (bf16*)(ws + WS_WD2);
    bf16* KMEM = (bf16*)(ws + WS_KMEM); bf16* VTM = (bf16*)(ws + WS_VT); bf16* MIX = (bf16*)(ws + WS_MIX); bf16* RB = (bf16*)(ws + WS_R); bf16* XG = (bf16*)(ws + WS_XG);
    bf16* ST = (bf16*)p.out;
    const float* x = p.in[0]; float* out = p.out;
    volatile LAS unsigned* MISC = (volatile LAS unsigned*)(lds + LDS_MISC);
    if (threadIdx.x < 16) MISC[threadIdx.x] = 0u;
    __syncthreads();
    const XcdBarrier xbar = xcd_barrier_post((unsigned*)(ws + WS_BAR), MISC);

    {
        FRESH_TID();
        LAS float* scr = (LAS float*)(lds + wave * 16896);
        const int gw = bid * 8 + wave, NGW = G * 8;
        for (int it = gw; it < N_EARLY; it += NGW) {
            int r = it;
            if (r < I_UP) { const int kb = r / 44, n0 = (r % 44) * 64; tr_tile<64>(p.in[3], DFF, DM, kb * 64, n0, W1CAT + (size_t)((n0 >> 7) * 256 + (n0 & 127)) * DM, scr, lane); continue; } r -= I_UP;
            if (r < I_UP) { const int kb = r / 44, n0 = (r % 44) * 64; tr_tile<64>(p.in[4], DFF, DM, kb * 64, n0, W1CAT + (size_t)((n0 >> 7) * 256 + 128 + (n0 & 127)) * DM, scr, lane); continue; } r -= I_UP;
            { const int kb = r / 32, n0 = (r % 32) * 64; tr_tile<64>(p.in[19], 2 * DM, DM, kb * 64, n0, W1CAT + (size_t)(2 * DFF + n0) * DM, scr, lane); }
        }
        for (int m = gw * 2; m < MTOK + BATCH * NMEM; m += NGW * 2) {
            if (m < MTOK) norm_rows2_bf16(x + (size_t)m * DM, x + (size_t)(m + 1) * DM, p.in[2], XG + (size_t)m * DM, XG + (size_t)(m + 1) * DM, lane);
            else norm_rows2_bf16(p.in[1] + (size_t)(m - MTOK) * DM, p.in[1] + (size_t)(m + 1 - MTOK) * DM, p.in[17], XG + (size_t)m * DM, XG + (size_t)(m + 1) * DM, lane);
        }
        for (int i = bid * 512 + tid; i < 3 * MTOK; i += G * 512) rowss[i] = 0.f;
    }
    xcd_barrier(xbar);

    {
        pg8::Gemm g{XG, W1CAT, MTOK + 512, 2 * DFF + 2 * DM, DM};
        OrderUpKV S; S.base.init(MTOK, 2 * DFF, G, bid); S.extra = 16;
        EpiUp E{RB, nullptr, KMEM, VTM, 2 * DFF / 256};
        pg8::gemm_phase<EpiUp, OrderUpKV, true, true>(lds, g, S, E);
        constexpr int NU = 2 * DFF / 256 * (MTOK / 256) + 16;
        const int rem = NU % G, nsp = rem ? G - rem : G, si = rem ? bid - rem : bid;
        if (si >= 0) {
            FRESH_TID();
            LAS float* scr = (LAS float*)(lds + wave * 16896);
            for (int it = si * 8 + wave; it < N_LATE; it += nsp * 8) {
                int r = it;
                if (r < I_DN) { const int kb = r / 16, n0 = (r % 16) * 64; tr_tile<64>(p.in[5], DM, DFF, kb * 64, n0, WD1 + (size_t)n0 * DFF, scr, lane); continue; } r -= I_DN;
                if (r < I_IN) { const int kb = r / 97, nb = r % 97, n0 = nb * 32;
                    bf16* dst = nb < 48 ? WIN + (size_t)n0 * DM : (nb == 48 ? WZ : WIN + (size_t)(n0 - 32) * DM);
                    tr_tile<32>(p.in[7], DIN, DM, kb * 64, n0, dst, scr, lane, p.in[6]); continue; } r -= I_IN;
                if (r < I_SQ) { const int kb = r / 16, n0 = (r % 16) * 64; tr_tile<64>(p.in[15], DM, DM, kb * 64, n0, WOUT + (size_t)n0 * DM, scr, lane); continue; } r -= I_SQ;
                if (r < I_SQ) { const int kb = r / 16, n0 = (r % 16) * 64; tr_tile<64>(p.in[18], DM, DM, kb * 64, n0, WQ + (size_t)n0 * DM, scr, lane, p.in[16]); continue; } r -= I_SQ;
                if (r < I_SQ) { const int kb = r / 16, n0 = (r % 16) * 64; tr_tile<64>(p.in[20], DM, DM, kb * 64, n0, WO + (size_t)n0 * DM, scr, lane); continue; } r -= I_SQ;
                if (r < I_UP) { const int kb = r / 44, n0 = (r % 44) * 64; tr_tile<64>(p.in[22], DFF, DM, kb * 64, n0, W2CAT + (size_t)((n0 >> 7) * 256 + (n0 & 127)) * DM, scr, lane, p.in[21]); continue; } r -= I_UP;
                if (r < I_UP) { const int kb = r / 44, n0 = (r % 44) * 64; tr_tile<64>(p.in[23], DFF, DM, kb * 64, n0, W2CAT + (size_t)((n0 >> 7) * 256 + 128 + (n0 & 127)) * DM, scr, lane, p.in[21]); continue; } r -= I_UP;
                { const int kb = r / 16, n0 = (r % 16) * 64; tr_tile<64>(p.in[24], DM, DFF, kb * 64, n0, WD2 + (size_t)n0 * DFF, scr, lane); }
            }
        }
    }
    xcd_barrier(xbar);
    {
        pg8::Gemm g{RB, WD1, MTOK, DM, DFF};
        pg8::StaticOrder S; S.init(MTOK, DM, G, bid);
        EpiResB E{x, XG, rowss, 0.5f};
        pg8::gemm_phase<EpiResB, pg8::StaticOrder, true, true>(lds, g, S, E);
    }
    xcd_barrier(xbar);
    {
        {
        pg8::Gemm g{XG, WIN, MTOK, NPROJ, DM};
        pg8::StaticOrder S; S.init(MTOK, NPROJ, G, bid);
        EpiScale E{RB, NPROJ, rowss, 1.f, true};
        pg8::gemm_phase<EpiScale, pg8::StaticOrder, true, true>(lds, g, S, E);
        }
        FRESH_TID();
        const int fr = lane & 15, fq = lane >> 4;
        for (int rb = bid; rb < MTOK / 64; rb += G) {
            const int row0 = rb * 64 + (wave >> 1) * 16, zc0 = (wave & 1) * 16;
            f32x4 acc0 = {0.f, 0.f, 0.f, 0.f}, acc1 = {0.f, 0.f, 0.f, 0.f};
            const float rsq = rowss[row0 + fr];
#pragma unroll 1
            for (int half = 0; half < 2; ++half) {
                v4u rg[12];
#pragma unroll
                for (int i = 0; i < 12; ++i) {
                    const int c = tid + 512 * i, row = c >> 6, c16 = c & 63;
                    const bf16* src = (row < 64 ? XG + (size_t)(rb * 64 + row) * DM : WZ + (size_t)(row - 64) * DM) + half * 512 + c16 * 8;
                    rg[i] = *(const v4u*)src;
                }
#pragma unroll
                for (int i = 0; i < 12; ++i) { const int c = tid + 512 * i; *(LAS v4u*)(lds + (c >> 6) * 1040 + (c & 63) * 16) = rg[i]; }
                __syncthreads();
                const LAS unsigned char* ap = lds + (64 + zc0 + fr) * 1040 + fq * 16; const LAS unsigned char* bp = lds + ((wave >> 1) * 16 + fr) * 1040 + fq * 16;
#pragma unroll
                for (int i = 0; i < 16; i += 2) {
                    acc0 = MFMA16(*(const LAS bf16x8*)(ap + i * 64), *(const LAS bf16x8*)(bp + i * 64), acc0);
                    acc1 = MFMA16(*(const LAS bf16x8*)(ap + (i + 1) * 64), *(const LAS bf16x8*)(bp + (i + 1) * 64), acc1);
                }
                __syncthreads();
            }
            const float rs = rsqrtf(rsq * (1.f / DM) + EPS);
            *(f32x4*)(zbuf + (size_t)(row0 + fr) * 32 + zc0 + fq * 4) = (acc0 + acc1) * rs;
        }
    }
    xcd_barrier(xbar);
    { FRESH_TID(); gla_g1(lds, zbuf, RB, p.in[8], p.in[9], p.in[10], p.in[11], decay, ST, p.in[13], p.in[14], MIX, G, bid, tid, wave, lane); }
    xcd_barrier(xbar);
    { FRESH_TID(); gla_g2(ST, decay, G, bid, tid); }
    xcd_barrier(xbar);
    { FRESH_TID(); gla_g3(lds, zbuf, RB, p.in[8], p.in[9], p.in[10], p.in[11], ST, p.in[12], MIX, G, bid, tid, wave, lane); }
    xcd_barrier(xbar);
    {
        pg8::Gemm g{MIX, WOUT, MTOK, DM, DM};
        pg8::StaticOrder S; S.init(MTOK, DM, G, bid);
        EpiResB E{nullptr, XG, rowss + MTOK, 1.f};
        pg8::gemm_phase<EpiResB, pg8::StaticOrder, true, true>(lds, g, S, E);
    }
    xcd_barrier(xbar);
    {
        pg8::Gemm g{XG, WQ, MTOK, DM, DM};
        pg8::StaticOrder S; S.init(MTOK, DM, G, bid);
        EpiScale E{MIX, DM, rowss + MTOK, 0.0625f * 1.4426950408889634f, false};
        pg8::gemm_phase<EpiScale, pg8::StaticOrder, true, true>(lds, g, S, E);
    }
    xcd_barrier(xbar);
    { FRESH_TID(); xattn_phase(lds, MIX, RB, KMEM, VTM, G, bid, tid, wave, lane); }
    xcd_barrier(xbar);
    {
        pg8::Gemm g{RB, WO, MTOK, DM, DM};
        pg8::StaticOrder S; S.init(MTOK, DM, G, bid);
        EpiResB E{nullptr, XG, rowss + 2 * MTOK, 1.f};
        pg8::gemm_phase<EpiResB, pg8::StaticOrder, true, true>(lds, g, S, E);
    }
    xcd_barrier(xbar);
    {
        pg8::Gemm g{XG, W2CAT, MTOK, 2 * DFF, DM};
        pg8::StaticOrder S; S.init(MTOK, 2 * DFF, G, bid);
        EpiUp E{RB, rowss + 2 * MTOK, nullptr, nullptr, 2 * DFF / 256};
        pg8::gemm_phase<EpiUp, pg8::StaticOrder, true, true>(lds, g, S, E);
    }
    xcd_barrier(xbar);
    if (G == MTOK / 256 * (DM / 256)) {
        pg8::Gemm g{RB, WD2, MTOK, DM, DFF};
        pg8::StaticOrder S; S.init(MTOK, DM, G, bid);
        EpiResNorm E{XG, out, p.in[25], 0.5f, (float*)(ws + WS_PART), (unsigned*)(ws + WS_BAR + 16384)};
        pg8::gemm_phase<EpiResNorm, pg8::StaticOrder, false, true>(lds, g, S, E);
    } else {
        {
            pg8::Gemm g{RB, WD2, MTOK, DM, DFF};
            pg8::StaticOrder S; S.init(MTOK, DM, G, bid);
            EpiResF E{XG, out, 0.5f};
            pg8::gemm_phase<EpiResF, pg8::StaticOrder, true, true>(lds, g, S, E);
        }
        xcd_barrier(xbar);
        {
            FRESH_TID();
            const int gw = bid * 8 + wave, NGW = G * 8;
            for (int m = gw; m < MTOK; m += NGW) {
                f32x4* xr = (f32x4*)(out + (size_t)m * DM) + lane; const f32x4* gr = (const f32x4*)p.in[25] + lane;
                f32x4 v[4]; float s = 0.f;
#pragma unroll
                for (int j = 0; j < 4; ++j) { v[j] = xr[64 * j]; s += (v[j][0] * v[j][0] + v[j][1] * v[j][1]) + (v[j][2] * v[j][2] + v[j][3] * v[j][3]); }
                const float rs = rsqrtf(wave_sum(s) * (1.f / DM) + EPS);
#pragma unroll
                for (int j = 0; j < 4; ++j) xr[64 * j] = v[j] * rs * gr[64 * j];
            }
        }
    }
}

extern "C" void kernel_launch(void* const* d_in, const int* in_sizes, int n_in, void* d_out, int out_size, void* d_ws, size_t ws_size, hipStream_t stream) {
    static int grid_blocks = 0;
    if (!grid_blocks) {
        if (n_in != 26 || out_size != MTOK * DM || ws_size < WS_END) { fprintf(stderr, "kernel_launch: unexpected shapes n_in=%d out=%d ws=%zu\n", n_in, out_size, ws_size); grid_blocks = -1; return; }
        int dev = 0, cus = 0, per_cu = 0;
        hipGetDevice(&dev);
        hipDeviceGetAttribute(&cus, hipDeviceAttributeMultiprocessorCount, dev);
        hipFuncSetAttribute((const void*)fwd_kernel, hipFuncAttributeMaxDynamicSharedMemorySize, LDS_BYTES);
        hipOccupancyMaxActiveBlocksPerMultiprocessor(&per_cu, (const void*)fwd_kernel, 512, LDS_BYTES);
        if (per_cu < 1) { fprintf(stderr, "kernel_launch: occupancy query says %d blocks/CU\n", per_cu); per_cu = 1; }
        grid_blocks = cus * per_cu;
    }
    if (grid_blocks < 0) return;
    if (hipMemsetAsync((char*)d_ws + WS_BAR, 0, 32768, stream) != hipSuccess) { fprintf(stderr, "kernel_launch: memset failed\n"); return; }
    Params p{};
    for (int i = 0; i < 26; ++i) p.in[i] = (const float*)d_in[i];
    p.out = (float*)d_out; p.ws = (unsigned char*)d_ws;
    void* args[] = {&p};
    hipError_t e = hipLaunchCooperativeKernel((const void*)fwd_kernel, dim3(grid_blocks), dim3(512), args, LDS_BYTES, stream);
    if (e != hipSuccess) fprintf(stderr, "cooperative launch failed: %s (grid %d)\n", hipGetErrorString(e), grid_blocks);
}
```

```cpp
#include <hip/hip_runtime.h>
#include <cstdio>
#include <cstdint>
namespace pg8 {
#define PG8_LAS __attribute__((address_space(3)))
typedef unsigned short bf16_t;
typedef short bf16x8 __attribute__((ext_vector_type(8)));
typedef float f32x4 __attribute__((ext_vector_type(4)));
typedef unsigned u32x4 __attribute__((ext_vector_type(4)));
constexpr int BM = 256, BK = 64, HALF = 128, HTB = HALF * BK * 2  , STAGE_BYTES = 8 * HTB, NXCD = 8, WGM = 8;

__host__ __device__ __forceinline__ int lds_byte(int r, int c) { const int st = (r >> 4) * 2 + (c >> 5), rr = r & 15, cc = c & 31, ob = rr * 64 + cc * 2; return st * 1024 + (ob ^ (((ob >> 9) & 1) << 5)); }
__host__ __device__ __forceinline__ void stage_rc(int b, int& R, int& C) { const int st = b / 1024, sb = b % 1024, swz = sb ^ (((sb >> 9) & 1) << 5); R = (st >> 1) * 16 + swz / 64; C = (st & 1) * 32 + (swz % 64) / 2; }
__host__ __device__ __forceinline__ int perm32(int rho) { const int n = rho >> 4, i = rho & 15; return 8 * (i >> 2) + 4 * n + (i & 3); }

struct Unit { int pm, pn; };
struct Gemm { const bf16_t* A; const bf16_t* Bt; int M, N, K; };

struct StaticOrder {
    int nM, nN, nwg, G, c;
    __host__ __device__ void init(int M, int N, int G_, int c_) { nM = M / BM; nN = N / BM; nwg = nM * nN; G = G_; c = c_; }
    __host__ __device__ bool next(int i, Unit& u) const {
        const long L = (long)i * G + c; if (L >= nwg) return false;
        int wgid = (int)L; { const int q = nwg / NXCD, r = nwg % NXCD, xcd = wgid % NXCD, off = wgid / NXCD; wgid = (xcd < r ? xcd * (q + 1) : r * (q + 1) + (xcd - r) * q) + off; }
        const int nig = WGM * nN, gid = wgid / nig, fm = gid * WGM, gsz = (nM - fm) < WGM ? (nM - fm) : WGM;
        u.pm = fm + ((wgid % nig) % gsz); u.pn = (wgid % nig) / gsz; return true;
    }
    __device__ __forceinline__ void a_ready(const Unit&) const {}
    __device__ __forceinline__ void done(const Unit&) const {}
};

__device__ __forceinline__ unsigned cvt_pk_bf16(float lo, float hi) { unsigned r; asm volatile("v_cvt_pk_bf16_f32 %0, %1, %2" : "=v"(r) : "v"(lo), "v"(hi)); return r; }
template <class Epi, class Sched, bool ALIGN_EPI = false, bool SP2 = false>
__device__ __forceinline__ void gemm_phase(PG8_LAS unsigned char* lds, const Gemm g, const Sched& S, const Epi& E) {
    int tid_l = threadIdx.x; asm volatile("" : "+v"(tid_l));
    const int tid = tid_l, wid = __builtin_amdgcn_readfirstlane(tid >> 6), lane = tid & 63, wr = wid >> 2, wc = wid & 3, fr = lane & 15, fq = lane >> 4;
    const int K = g.K, nt = K / BK;
    unsigned voffA[2], voffB[2];
#pragma unroll
    for (int i = 0; i < 2; ++i) { int R, C; stage_rc(tid * 16 + i * 8192, R, C); const int Rb = Epi::PERM ? ((R & ~31) + perm32(R & 31)) : R;
        voffA[i] = (unsigned)(R * K + C) * 2u; voffB[i] = (unsigned)(Rb * K + C) * 2u; }
    const size_t kstep = (size_t)(BK * 2);
    const size_t hstep = (size_t)HALF * K * 2;
    const size_t tstep = 2 * hstep;
    const unsigned ldsw = (unsigned)wid * 1024u;
    const int aoff = lds_byte(wr * 64 + fr, fq * 8), boff = lds_byte(wc * 32 + fr, fq * 8);
#define PG8_SA(b, h) (((b) * 2 + (h)) * HTB)
#define PG8_SB(b, h) ((4 + (b) * 2 + (h)) * HTB)
#define PG8_STAGE(bufoff, gbase, voff) do { _Pragma("unroll") for (int _i = 0; _i < 2; ++_i) \
        __builtin_amdgcn_global_load_lds((const unsigned*)((const char*)(gbase) + (voff)[_i]), (PG8_LAS unsigned*)(lds + (bufoff) + ldsw + _i * 8192), 16, 0, 0); } while (0)
#define PG8_LDA(dst, b, h) do { _Pragma("unroll") for (int m = 0; m < 4; ++m) _Pragma("unroll") for (int k = 0; k < 2; ++k) dst[m][k] = *(const PG8_LAS bf16x8*)(lds + PG8_SA(b, h) + aoff + m * 2048 + k * 1024); } while (0)
#define PG8_LDB(dst, b, h) do { _Pragma("unroll") for (int n = 0; n < 2; ++n) _Pragma("unroll") for (int k = 0; k < 2; ++k) dst[n][k] = *(const PG8_LAS bf16x8*)(lds + PG8_SB(b, h) + boff + n * 2048 + k * 1024); } while (0)
#define PG8_MMA(ai, bj, At, Bt) do { __builtin_amdgcn_s_setprio(1); _Pragma("unroll") for (int m = 0; m < 4; ++m) _Pragma("unroll") for (int n = 0; n < 2; ++n) _Pragma("unroll") for (int k = 0; k < 2; ++k) \
        acc[ai][bj][m][n] = __builtin_amdgcn_mfma_f32_16x16x32_bf16(Bt[n][k], At[m][k], acc[ai][bj][m][n], 0, 0, 0); __builtin_amdgcn_s_setprio(0); } while (0)
#define PG8_WAIT_V(n) asm volatile("s_waitcnt vmcnt(" #n ")" ::: "memory")
#define PG8_WAIT_L(n) asm volatile("s_waitcnt lgkmcnt(" #n ")" ::: "memory")
#define PG8_BAR __builtin_amdgcn_s_barrier()
#define PG8_SCHED __builtin_amdgcn_sched_barrier(0)
    Unit cur, nxt; int ui = 0;
    if (!S.next(0, cur)) return;
    f32x4 acc[2][2][4][2];
#pragma unroll
    for (int a = 0; a < 2; ++a)
#pragma unroll
        for (int b = 0; b < 2; ++b)
#pragma unroll
            for (int m = 0; m < 4; ++m)
#pragma unroll
                for (int n = 0; n < 2; ++n) acc[a][b][m][n] = (f32x4){0.f, 0.f, 0.f, 0.f};
    bf16x8 At[4][2], B0[2][2], B1[2][2];
    const char* cA = (const char*)g.A + (size_t)cur.pm * tstep; const char* cB = (const char*)g.Bt + (size_t)cur.pn * tstep;
    S.a_ready(cur);
    if constexpr (SP2) {
        PG8_STAGE(PG8_SB(0, 0), cB, voffB); PG8_STAGE(PG8_SB(0, 1), cB + hstep, voffB); PG8_STAGE(PG8_SA(0, 0), cA, voffA); PG8_STAGE(PG8_SA(0, 1), cA + hstep, voffA);
        if (wr == 1) PG8_BAR;
        PG8_WAIT_V(2); PG8_BAR;
        PG8_STAGE(PG8_SB(1, 0), cB + kstep, voffB); PG8_STAGE(PG8_SA(1, 0), cA + kstep, voffA); PG8_STAGE(PG8_SB(1, 1), cB + hstep + kstep, voffB);
        PG8_WAIT_V(6); PG8_BAR;
    } else {
        PG8_STAGE(PG8_SB(0, 0), cB, voffB); PG8_STAGE(PG8_SA(0, 0), cA, voffA); PG8_STAGE(PG8_SB(0, 1), cB + hstep, voffB); PG8_STAGE(PG8_SA(0, 1), cA + hstep, voffA);
        if (wr == 1) PG8_BAR;
        PG8_WAIT_V(4); PG8_BAR;
        PG8_STAGE(PG8_SB(1, 0), cB + kstep, voffB); PG8_STAGE(PG8_SA(1, 0), cA + kstep, voffA); PG8_STAGE(PG8_SB(1, 1), cB + hstep + kstep, voffB);
        PG8_WAIT_V(6); PG8_BAR;
    }
    for (;;) {
        const bool has_next = S.next(ui + 1, nxt);
        const char* nA = has_next ? (const char*)g.A + (size_t)nxt.pm * tstep : cA; const char* nB = has_next ? (const char*)g.Bt + (size_t)nxt.pn * tstep : cB;
        for (int t = 0; t < nt; t += 2) {
            const bool last = (t == nt - 2);
            const char* a1 = cA + (size_t)(t + 1) * kstep;
            const char* a2 = last ? nA : cA + (size_t)(t + 2) * kstep; const char* b2 = last ? nB : cB + (size_t)(t + 2) * kstep;
            const char* a3 = a2 + kstep; const char* b3 = b2 + kstep;
            if (last && has_next) S.a_ready(nxt);
            if constexpr (SP2) {
            PG8_LDB(B0, 0, 0); PG8_LDB(B1, 0, 1); PG8_SCHED; PG8_LDA(At, 0, 0); PG8_STAGE(PG8_SA(1, 1), a1 + hstep, voffA);
            PG8_WAIT_V(8); PG8_WAIT_L(0); PG8_BAR; PG8_MMA(0, 0, At, B0); PG8_MMA(0, 1, At, B1); PG8_BAR; PG8_SCHED;
            PG8_LDA(At, 0, 1); PG8_STAGE(PG8_SB(0, 0), b2, voffB); PG8_STAGE(PG8_SB(0, 1), b2 + hstep, voffB); PG8_STAGE(PG8_SA(0, 0), a2, voffA);
            PG8_WAIT_V(8); PG8_WAIT_L(0); PG8_BAR; PG8_MMA(1, 0, At, B0); PG8_MMA(1, 1, At, B1); PG8_BAR; PG8_SCHED;
            PG8_LDB(B0, 1, 0); PG8_LDB(B1, 1, 1); PG8_SCHED; PG8_LDA(At, 1, 0); PG8_STAGE(PG8_SA(0, 1), a2 + hstep, voffA);
            PG8_WAIT_V(8); PG8_WAIT_L(0); PG8_BAR; PG8_MMA(0, 0, At, B0); PG8_MMA(0, 1, At, B1); PG8_BAR; PG8_SCHED;
            PG8_LDA(At, 1, 1); PG8_STAGE(PG8_SB(1, 0), b3, voffB); PG8_STAGE(PG8_SB(1, 1), b3 + hstep, voffB); PG8_STAGE(PG8_SA(1, 0), a3, voffA);
            PG8_WAIT_V(8); PG8_WAIT_L(0); PG8_BAR; PG8_MMA(1, 0, At, B0); PG8_MMA(1, 1, At, B1); PG8_BAR; PG8_SCHED;
            } else {
            PG8_LDB(B0, 0, 0); PG8_SCHED; PG8_LDA(At, 0, 0); PG8_STAGE(PG8_SA(1, 1), a1 + hstep, voffA);
            PG8_WAIT_L(8); PG8_BAR; PG8_WAIT_L(0); PG8_MMA(0, 0, At, B0); PG8_BAR; PG8_SCHED;
            PG8_LDB(B1, 0, 1); PG8_STAGE(PG8_SB(0, 0), b2, voffB);
            PG8_BAR; PG8_WAIT_L(0); PG8_MMA(0, 1, At, B1); PG8_BAR;
            PG8_LDA(At, 0, 1); PG8_STAGE(PG8_SA(0, 0), a2, voffA);
            PG8_BAR; PG8_WAIT_L(0); PG8_MMA(1, 0, At, B0); PG8_BAR; PG8_SCHED;
            PG8_STAGE(PG8_SB(0, 1), b2 + hstep, voffB);
            PG8_WAIT_V(6); PG8_BAR; PG8_MMA(1, 1, At, B1); PG8_BAR;
            PG8_LDB(B0, 1, 0); PG8_SCHED; PG8_LDA(At, 1, 0); PG8_STAGE(PG8_SA(0, 1), a2 + hstep, voffA);
            PG8_WAIT_L(8); PG8_BAR; PG8_WAIT_L(0); PG8_MMA(0, 0, At, B0); PG8_BAR; PG8_SCHED;
            PG8_LDB(B1, 1, 1); PG8_STAGE(PG8_SB(1, 0), b3, voffB);
            PG8_BAR; PG8_WAIT_L(0); PG8_MMA(0, 1, At, B1); PG8_BAR;
            PG8_LDA(At, 1, 1); PG8_STAGE(PG8_SA(1, 0), a3, voffA);
            PG8_BAR; PG8_WAIT_L(0); PG8_MMA(1, 0, At, B0); PG8_BAR; PG8_SCHED;
            PG8_STAGE(PG8_SB(1, 1), b3 + hstep, voffB);
            PG8_WAIT_V(6); PG8_BAR; PG8_MMA(1, 1, At, B1); PG8_BAR;
            }
        }
        if constexpr (ALIGN_EPI) { if (wr == 0) PG8_BAR; }
        if constexpr (!Epi::AFTER_DRAIN) { E(acc, cur, wr, wc, fr, fq); S.done(cur); }
        if (!has_next) break;
#pragma unroll
        for (int a = 0; a < 2; ++a)
#pragma unroll
            for (int b = 0; b < 2; ++b)
#pragma unroll
                for (int m = 0; m < 4; ++m)
#pragma unroll
                    for (int n = 0; n < 2; ++n) acc[a][b][m][n] = (f32x4){0.f, 0.f, 0.f, 0.f};
        cur = nxt; cA = nA; cB = nB; ++ui;
        if constexpr (ALIGN_EPI) { if (wr == 1) PG8_BAR; }
    }
    PG8_WAIT_V(0);
    if constexpr (!ALIGN_EPI) { if (wr == 0) PG8_BAR; }
    PG8_BAR;
    if constexpr (Epi::AFTER_DRAIN) { E.fused(acc, cur, wr, wc, fr, fq, lds, wid, lane); S.done(cur); }
#undef PG8_SA
#undef PG8_SB
#undef PG8_STAGE
#undef PG8_LDA
#undef PG8_LDB
#undef PG8_MMA
#undef PG8_WAIT_V
#undef PG8_WAIT_L
#undef PG8_BAR
#undef PG8_SCHED
}
}

constexpr int DM = 1024, BATCH = 2, SEQ = 8192, MTOK = BATCH * SEQ, NMEM = 256, DFF = 2816, DIN = 3104, NPROJ = 3072;
constexpr float EPS = 1e-6f;
constexpr size_t MiB = 1u << 20;
constexpr size_t WS_ROWSS = 0;
constexpr size_t WS_Z = 1 * MiB;
constexpr size_t WS_DECAY = 3 * MiB;
constexpr size_t WS_W1CAT = 4 * MiB;
constexpr size_t WS_WD1 = 19 * MiB;
constexpr size_t WS_WIN = 25 * MiB;
constexpr size_t WS_WZ = 31 * MiB;
constexpr size_t WS_WOUT = 32 * MiB, WS_WQ = 34 * MiB, WS_WO = 36 * MiB;
constexpr size_t WS_W2CAT = 38 * MiB;
constexpr size_t WS_WD2 = 49 * MiB;
constexpr size_t WS_KMEM = 55 * MiB;
constexpr size_t WS_VT = 56 * MiB;
constexpr size_t WS_MIX = 58 * MiB;
constexpr size_t WS_R = 90 * MiB;
constexpr size_t WS_XG = 186 * MiB;
constexpr size_t WS_ST = 186 * MiB;
constexpr size_t WS_END = 256 * MiB;
constexpr size_t WS_PART = 256 * 1024;
constexpr size_t WS_BAR = 768 * 1024;
constexpr int LDS_MISC = 135168;
constexpr int LDS_BYTES = LDS_MISC + 64;

#define LAS __attribute__((address_space(3)))
typedef unsigned short bf16;
typedef unsigned v4u __attribute__((ext_vector_type(4)));
typedef unsigned v2u __attribute__((ext_vector_type(2)));
typedef float f32x4 __attribute__((ext_vector_type(4)));
typedef short bf16x8 __attribute__((ext_vector_type(8)));
#define LDS_WAIT() asm volatile("s_waitcnt lgkmcnt(0)" ::: "memory")

typedef float f32x2v __attribute__((ext_vector_type(2)));
typedef __bf16 bf16x2v __attribute__((ext_vector_type(2)));
__device__ __forceinline__ unsigned pk2(float lo, float hi) { const f32x2v v = {lo, hi}; const bf16x2v b = __builtin_convertvector(v, bf16x2v); return __builtin_bit_cast(unsigned, b); }
__device__ __forceinline__ float bflo(unsigned w) { return __uint_as_float(w << 16); }
__device__ __forceinline__ float bfhi(unsigned w) { return __uint_as_float(w & 0xffff0000u); }
__device__ __forceinline__ float silu_f(float x) { return x * __builtin_amdgcn_rcpf(1.f + __expf(-x)); }
__device__ __forceinline__ float logsig_f(float a) { return fminf(a, 0.f) - __logf(1.f + __expf(-fabsf(a))); }
__device__ __forceinline__ float wave_sum(float v) {
#pragma unroll
    for (int o = 1; o < 64; o <<= 1) v += __shfl_xor(v, o);
    return v;
}
__device__ __forceinline__ bf16x8 mk8(unsigned a, unsigned b, unsigned c, unsigned d) { v4u w = {a, b, c, d}; return __builtin_bit_cast(bf16x8, w); }
#define MFMA16(a, b, c) __builtin_amdgcn_mfma_f32_16x16x32_bf16((a), (b), (c), 0, 0, 0)

struct EpiUp {
    static constexpr bool PERM = true, AFTER_DRAIN = false;
    bf16* act; const float* rowss; bf16* Kmem; bf16* VT; int npn_main;
    __device__ __forceinline__ void operator()(const pg8::f32x4 (&acc)[2][2][4][2], const pg8::Unit& u, int wr, int wc, int fr, int fq) const {
        if (u.pn < npn_main) {
            const int row0 = u.pm * 256 + wr * 64 + fr, col0 = u.pn * 128 + wc * 32 + 8 * fq;
            float rsv[2][4];
#pragma unroll
            for (int ai = 0; ai < 2; ++ai)
#pragma unroll
                for (int m = 0; m < 4; ++m) rsv[ai][m] = rowss ? rowss[row0 + ai * 128 + m * 16] : 0.f;
#pragma unroll
            for (int ai = 0; ai < 2; ++ai)
#pragma unroll
                for (int m = 0; m < 4; ++m) {
                    const int r = row0 + ai * 128 + m * 16;
                    const float rs = rowss ? rsqrtf(rsv[ai][m] * (1.f / DM) + EPS) : 1.f;
                    float o[8];
#pragma unroll
                    for (int n = 0; n < 2; ++n)
#pragma unroll
                        for (int i = 0; i < 4; ++i) { const float g = acc[ai][0][m][n][i] * rs, uu = acc[ai][1][m][n][i] * rs; o[n * 4 + i] = silu_f(g) * uu; }
                    v4u w = {pk2(o[0], o[1]), pk2(o[2], o[3]), pk2(o[4], o[5]), pk2(o[6], o[7])};
                    *(v4u*)(act + (size_t)r * DFF + col0) = w;
                }
        } else {
            const int hsel = u.pn - npn_main;
            const int mt0 = (u.pm - MTOK / 256) * 256 + wr * 64 + fr;
#pragma unroll
            for (int ai = 0; ai < 2; ++ai)
#pragma unroll
                for (int m = 0; m < 4; ++m) {
                    const int mt = mt0 + ai * 128 + m * 16, b = mt >> 8, key = mt & 255;
#pragma unroll
                    for (int bj = 0; bj < 2; ++bj) {
                        const int d0 = bj * 128 + wc * 32 + 8 * fq;
                        const f32x4 v0 = acc[ai][bj][m][0], v1 = acc[ai][bj][m][1];
                        if (hsel < 4) {
                            v4u w = {pk2(v0[0], v0[1]), pk2(v0[2], v0[3]), pk2(v1[0], v1[1]), pk2(v1[2], v1[3])};
                            *(v4u*)(Kmem + ((size_t)((b * 4 + hsel) * 256 + key)) * 256 + d0) = w;
                        } else {
                            bf16* dst = VT + ((size_t)((b * 4 + hsel - 4) * 256 + d0)) * 256 + key;
                            const unsigned w0 = pk2(v0[0], v0[1]), w1 = pk2(v0[2], v0[3]), w2 = pk2(v1[0], v1[1]), w3 = pk2(v1[2], v1[3]);
                            dst[0 * 256] = (bf16)(w0 & 0xffffu); dst[1 * 256] = (bf16)(w0 >> 16); dst[2 * 256] = (bf16)(w1 & 0xffffu); dst[3 * 256] = (bf16)(w1 >> 16);
                            dst[4 * 256] = (bf16)(w2 & 0xffffu); dst[5 * 256] = (bf16)(w2 >> 16); dst[6 * 256] = (bf16)(w3 & 0xffffu); dst[7 * 256] = (bf16)(w3 >> 16);
                        }
                    }
                }
        }
    }
};
struct EpiResF {
    static constexpr bool PERM = false, AFTER_DRAIN = false;
    const bf16* base; float* out; float alpha;
    __device__ __forceinline__ void operator()(const pg8::f32x4 (&acc)[2][2][4][2], const pg8::Unit& u, int wr, int wc, int fr, int fq) const {
        const int row0 = u.pm * 256 + wr * 64 + fr, col0 = u.pn * 256 + wc * 32 + 4 * fq;
#pragma unroll
        for (int ai = 0; ai < 2; ++ai)
#pragma unroll
            for (int m = 0; m < 4; ++m) {
                const size_t off = (size_t)(row0 + ai * 128 + m * 16) * DM + col0;
#pragma unroll
                for (int bj = 0; bj < 2; ++bj)
#pragma unroll
                    for (int n = 0; n < 2; ++n) {
                        const v2u bw = *(const v2u*)(base + off + bj * 128 + n * 16);
                        const f32x4 bs = {bflo(bw.x), bfhi(bw.x), bflo(bw.y), bfhi(bw.y)};
                        *(f32x4*)(out + off + bj * 128 + n * 16) = bs + acc[ai][bj][m][n] * alpha;
                    }
            }
    }
};
struct EpiResB {
    static constexpr bool PERM = true, AFTER_DRAIN = false;
    const float* basef; bf16* xs; float* rowss; float alpha;
    __device__ __forceinline__ void operator()(const pg8::f32x4 (&acc)[2][2][4][2], const pg8::Unit& u, int wr, int wc, int fr, int fq) const {
        const int row0 = u.pm * 256 + wr * 64 + fr, col0 = u.pn * 256 + wc * 32 + 8 * fq;
#pragma unroll
        for (int ai = 0; ai < 2; ++ai) {
            f32x4 b0[4][2], b1[4][2];
            if (basef) {
#pragma unroll
                for (int m = 0; m < 4; ++m)
#pragma unroll
                    for (int bj = 0; bj < 2; ++bj) { const float* bp = basef + (size_t)(row0 + ai * 128 + m * 16) * DM + col0 + bj * 128; b0[m][bj] = __builtin_nontemporal_load((const f32x4*)bp); b1[m][bj] = __builtin_nontemporal_load((const f32x4*)(bp + 4));     }
            } else {
                v4u bw[4][2];
#pragma unroll
                for (int m = 0; m < 4; ++m)
#pragma unroll
                    for (int bj = 0; bj < 2; ++bj) bw[m][bj] = *(const v4u*)(xs + (size_t)(row0 + ai * 128 + m * 16) * DM + col0 + bj * 128);
#pragma unroll
                for (int m = 0; m < 4; ++m)
#pragma unroll
                    for (int bj = 0; bj < 2; ++bj) { const v4u w = bw[m][bj]; b0[m][bj] = (f32x4){bflo(w.x), bfhi(w.x), bflo(w.y), bfhi(w.y)}; b1[m][bj] = (f32x4){bflo(w.z), bfhi(w.z), bflo(w.w), bfhi(w.w)}; }
            }
#pragma unroll
            for (int m = 0; m < 4; ++m) {
                const int r = row0 + ai * 128 + m * 16; const size_t off = (size_t)r * DM + col0; float ss = 0.f;
#pragma unroll
                for (int bj = 0; bj < 2; ++bj) {
                    const f32x4 v0 = b0[m][bj] + acc[ai][bj][m][0] * alpha, v1 = b1[m][bj] + acc[ai][bj][m][1] * alpha;
                    ss += ((v0[0] * v0[0] + v0[1] * v0[1]) + (v0[2] * v0[2] + v0[3] * v0[3])) + ((v1[0] * v1[0] + v1[1] * v1[1]) + (v1[2] * v1[2] + v1[3] * v1[3]));
                    *(v4u*)(xs + off + bj * 128) = (v4u){pk2(v0[0], v0[1]), pk2(v0[2], v0[3]), pk2(v1[0], v1[1]), pk2(v1[2], v1[3])};
                }
                ss += __shfl_xor(ss, 16); ss += __shfl_xor(ss, 32); if (fq == 0) atomicAdd(rowss + r, ss);
            }
        }
    }
};
struct EpiScale {
    static constexpr bool PERM = true, AFTER_DRAIN = false;
    bf16* O; int ldc; const float* rowss; float scale; bool nt;
    __device__ __forceinline__ void operator()(const pg8::f32x4 (&acc)[2][2][4][2], const pg8::Unit& u, int wr, int wc, int fr, int fq) const {
        const int row0 = u.pm * 256 + wr * 64 + fr, col0 = u.pn * 256 + wc * 32 + 8 * fq;
        float rsv[2][4];
#pragma unroll
        for (int ai = 0; ai < 2; ++ai)
#pragma unroll
            for (int m = 0; m < 4; ++m) rsv[ai][m] = rowss[row0 + ai * 128 + m * 16];
#pragma unroll
        for (int ai = 0; ai < 2; ++ai)
#pragma unroll
            for (int m = 0; m < 4; ++m) {
                const int r = row0 + ai * 128 + m * 16;
                const float rs = rsqrtf(rsv[ai][m] * (1.f / DM) + EPS) * scale;
#pragma unroll
                for (int bj = 0; bj < 2; ++bj) {
                    const f32x4 v0 = acc[ai][bj][m][0] * rs, v1 = acc[ai][bj][m][1] * rs;
                    v4u w = {pk2(v0[0], v0[1]), pk2(v0[2], v0[3]), pk2(v1[0], v1[1]), pk2(v1[2], v1[3])};
                    if (nt) __builtin_nontemporal_store(w, (v4u*)(O + (size_t)r * ldc + col0 + bj * 128)); else *(v4u*)(O + (size_t)r * ldc + col0 + bj * 128) = w;
                }
            }
    }
};
struct EpiResNorm {
    static constexpr bool PERM = false, AFTER_DRAIN = true;
    const bf16* base; float* out; const float* gain; float alpha; float* part; unsigned* cnt;
    __device__ __forceinline__ void fused(pg8::f32x4 (&acc)[2][2][4][2], const pg8::Unit& u, int wr, int wc, int fr, int fq, PG8_LAS unsigned char* lds, int wid, int lane) const {
        const int row0 = u.pm * 256 + wr * 64 + fr, col0 = u.pn * 256 + wc * 32 + 4 * fq;
        LAS float* P = (LAS float*)lds;
        LAS float* S = (LAS float*)(lds + 4096);
#pragma unroll
        for (int ai = 0; ai < 2; ++ai) {
            v2u bw[4][2][2];
#pragma unroll
            for (int m = 0; m < 4; ++m)
#pragma unroll
                for (int bj = 0; bj < 2; ++bj)
#pragma unroll
                    for (int n = 0; n < 2; ++n) bw[m][bj][n] = *(const v2u*)(base + (size_t)(row0 + ai * 128 + m * 16) * DM + col0 + bj * 128 + n * 16);
#pragma unroll
            for (int m = 0; m < 4; ++m) {
                float ss = 0.f;
#pragma unroll
                for (int bj = 0; bj < 2; ++bj)
#pragma unroll
                    for (int n = 0; n < 2; ++n) {
                        const v2u w = bw[m][bj][n];
                        const f32x4 bs = {bflo(w.x), bfhi(w.x), bflo(w.y), bfhi(w.y)};
                        const f32x4 v = bs + acc[ai][bj][m][n] * alpha;
                        acc[ai][bj][m][n] = v;
                        ss += (v[0] * v[0] + v[1] * v[1]) + (v[2] * v[2] + v[3] * v[3]);
                    }
                ss += __shfl_xor(ss, 16); ss += __shfl_xor(ss, 32);
                if (fq == 0) P[(ai * 128 + wr * 64 + m * 16 + fr) * 4 + wc] = ss;
            }
        }
        __syncthreads();
        const int tid = wid * 64 + lane;
        if (tid < 256) {
            const float t = (P[tid * 4] + P[tid * 4 + 1]) + (P[tid * 4 + 2] + P[tid * 4 + 3]);
            __hip_atomic_store(part + (size_t)(u.pm * 256 + tid) * 4 + u.pn, t, __ATOMIC_RELAXED, __HIP_MEMORY_SCOPE_AGENT);
        }
        asm volatile("s_waitcnt vmcnt(0)" ::: "memory");
        __syncthreads();
        if (tid == 0) {
            __hip_atomic_fetch_add(cnt + 64 * u.pm, 1u, __ATOMIC_RELEASE, __HIP_MEMORY_SCOPE_AGENT);
            unsigned sp = 0;
            while (__hip_atomic_load(cnt + 64 * u.pm, __ATOMIC_RELAXED, __HIP_MEMORY_SCOPE_AGENT) < 4u && ++sp < (1u << 22)) __builtin_amdgcn_s_sleep(2);
            __builtin_amdgcn_fence(__ATOMIC_ACQUIRE, "agent");
        }
        __syncthreads();
        if (tid < 256) {
            const float* pp = part + (size_t)(u.pm * 256 + tid) * 4;
            const float t = (__hip_atomic_load(pp, __ATOMIC_RELAXED, __HIP_MEMORY_SCOPE_AGENT) + __hip_atomic_load(pp + 1, __ATOMIC_RELAXED, __HIP_MEMORY_SCOPE_AGENT))
                          + (__hip_atomic_load(pp + 2, __ATOMIC_RELAXED, __HIP_MEMORY_SCOPE_AGENT) + __hip_atomic_load(pp + 3, __ATOMIC_RELAXED, __HIP_MEMORY_SCOPE_AGENT));
            S[tid] = rsqrtf(t * (1.f / DM) + EPS);
        }
        __syncthreads();
        f32x4 gv[2][2];
#pragma unroll
        for (int bj = 0; bj < 2; ++bj)
#pragma unroll
            for (int n = 0; n < 2; ++n) gv[bj][n] = *(const f32x4*)(gain + col0 + bj * 128 + n * 16);
#pragma unroll
        for (int ai = 0; ai < 2; ++ai)
#pragma unroll
            for (int m = 0; m < 4; ++m) {
                const int rl = ai * 128 + wr * 64 + m * 16 + fr; const float rs = S[rl]; const size_t off = (size_t)(u.pm * 256 + rl) * DM + col0;
#pragma unroll
                for (int bj = 0; bj < 2; ++bj)
#pragma unroll
                    for (int n = 0; n < 2; ++n) { f32x4 ov = acc[ai][bj][m][n] * rs * gv[bj][n];
                        *(f32x4*)(out + off + bj * 128 + n * 16) = ov; }
            }
    }
};
struct OrderUpKV {
    pg8::StaticOrder base; int extra;
    __device__ bool next(int i, pg8::Unit& u) const {
        long L = (long)i * base.G + base.c;
        if (L < base.nwg) return base.next(i, u);
        L -= base.nwg; if (L >= extra) return false;
        u.pm = MTOK / 256 + (int)(L / 8); u.pn = base.nN + (int)(L % 8); return true;
    }
    __device__ __forceinline__ void a_ready(const pg8::Unit&) const {}
    __device__ __forceinline__ void done(const pg8::Unit&) const {}
};

template <int NW>
__device__ __forceinline__ void tr_tile(const float* __restrict__ W, int N, int K, int k0, int n0, bf16* orow0, LAS float* scr, int lane, const float* gain = nullptr) {
    constexpr int LPR = NW / 4, RPI = 64 / LPR, NI = 64 / RPI, STR = NW + 1, NO = NW * 8 / 64;
    const int kr = lane / LPR, nc = (lane % LPR) * 4;
    f32x4 v[NI];
#pragma unroll
    for (int i = 0; i < NI; ++i) v[i] = __builtin_nontemporal_load((const f32x4*)(W + (size_t)(k0 + i * RPI + kr) * N + n0 + nc));
    if (gain) {
#pragma unroll
        for (int i = 0; i < NI; ++i) v[i] = v[i] * gain[k0 + i * RPI + kr];
    }
#pragma unroll
    for (int i = 0; i < NI; ++i) { LAS float* d = scr + (i * RPI + kr) * STR + nc; d[0] = v[i][0]; d[1] = v[i][1]; d[2] = v[i][2]; d[3] = v[i][3]; }
    LDS_WAIT();
#pragma unroll
    for (int j = 0; j < NO; ++j) {
        const int idx = j * 64 + lane, c = idx & 7, n = idx >> 3; const LAS float* sp = scr + (8 * c) * STR + n;
        v4u o; o.x = pk2(sp[0 * STR], sp[1 * STR]); o.y = pk2(sp[2 * STR], sp[3 * STR]); o.z = pk2(sp[4 * STR], sp[5 * STR]); o.w = pk2(sp[6 * STR], sp[7 * STR]);
        *(v4u*)(orow0 + (size_t)n * K + k0 + 8 * c) = o;
    }
    LDS_WAIT();
}
__device__ __forceinline__ void norm_rows2_bf16(const float* x0, const float* x1, const float* gain, bf16* o0, bf16* o1, int lane) {
    const f32x4* xr0 = (const f32x4*)x0 + lane; const f32x4* xr1 = (const f32x4*)x1 + lane; const f32x4* gr = (const f32x4*)gain + lane;
    f32x4 v0[4], v1[4]; float s0 = 0.f, s1 = 0.f;
#pragma unroll
    for (int j = 0; j < 4; ++j) { v0[j] = __builtin_nontemporal_load(xr0 + 64 * j); v1[j] = __builtin_nontemporal_load(xr1 + 64 * j); }
#pragma unroll
    for (int j = 0; j < 4; ++j) { s0 += (v0[j][0] * v0[j][0] + v0[j][1] * v0[j][1]) + (v0[j][2] * v0[j][2] + v0[j][3] * v0[j][3]); s1 += (v1[j][0] * v1[j][0] + v1[j][1] * v1[j][1]) + (v1[j][2] * v1[j][2] + v1[j][3] * v1[j][3]); }
    const float r0 = rsqrtf(wave_sum(s0) * (1.f / DM) + EPS), r1 = rsqrtf(wave_sum(s1) * (1.f / DM) + EPS);
    v2u* p0 = (v2u*)o0 + lane; v2u* p1 = (v2u*)o1 + lane;
#pragma unroll
    for (int j = 0; j < 4; ++j) { const f32x4 gg = gr[64 * j]; const f32x4 t0 = v0[j] * r0 * gg, t1 = v1[j] * r1 * gg;
        p0[64 * j] = (v2u){pk2(t0[0], t0[1]), pk2(t0[2], t0[3])}; p1[64 * j] = (v2u){pk2(t1[0], t1[1]), pk2(t1[2], t1[3])}; }
}

constexpr int GL_STR = 72;
constexpr int GL_A0 = 0, GL_A1 = 9216, GL_A2 = 18432, GL_A3 = 27648, GL_VT = 36864, GL_SS = 36864 + 18432;

struct GlaIn { unsigned short qr[4][4], kr[4][4]; float bw[4]; float bias; f32x4 zv[4]; v4u vraw[2]; };
__device__ __forceinline__ void gla_front_load(GlaIn& R, const float* z, const bf16* proj, const float* gfw, const float* gfb, const float* gbw, const float* gbb,
                                               int b, int h, int n, int tid, int wave, int lane) {
    const int fr = lane & 15, fq = lane >> 4, jt = wave & 3, dir = wave >> 2;
    const int T0 = b * SEQ + n * 64, col = h * 64 + jt * 16 + fr;
    const float* gw = dir ? gbw : gfw; const float* gbias = dir ? gbb : gfb;
#pragma unroll
    for (int tt = 0; tt < 4; ++tt)
#pragma unroll
        for (int i = 0; i < 4; ++i) { const bf16* pr = proj + (size_t)(T0 + tt * 16 + fq * 4 + i) * NPROJ + col; R.qr[tt][i] = pr[0]; R.kr[tt][i] = pr[256]; }
#pragma unroll
    for (int ks = 0; ks < 4; ++ks) R.bw[ks] = gw[(fq * 4 + ks) * 256 + col];
    R.bias = gbias[col];
#pragma unroll
    for (int tt = 0; tt < 4; ++tt) R.zv[tt] = *(const f32x4*)(z + (size_t)(T0 + tt * 16 + fr) * 32 + dir * 16 + fq * 4);
#pragma unroll
    for (int i = 0; i < 2; ++i) { const int cc = tid + 512 * i; R.vraw[i] = *(const v4u*)(proj + (size_t)(T0 + (cc & 63)) * NPROJ + 512 + h * 128 + (cc >> 6) * 8); }
}
template <bool G1>
__device__ __forceinline__ void gla_front_compute(const GlaIn& R, LAS unsigned char* lds, float* decay, int b, int h, int n, int tid, int wave, int lane) {
    const int fr = lane & 15, fq = lane >> 4, jt = wave & 3, dir = wave >> 2, bh = b * 4 + h;
    float g[4][4], c[4][4];
#pragma unroll
    for (int tt = 0; tt < 4; ++tt) {
        f32x4 a = {R.bias, R.bias, R.bias, R.bias};
#pragma unroll
        for (int ks = 0; ks < 4; ++ks) a = __builtin_amdgcn_mfma_f32_16x16x4f32(R.zv[tt][ks], R.bw[ks], a, 0, 0, 0);
#pragma unroll
        for (int i = 0; i < 4; ++i) g[tt][i] = logsig_f(a[i]) * (1.f / 16.f);
    }
    float base = 0.f;
#pragma unroll
    for (int tt = 0; tt < 4; ++tt) {
        const float p0 = g[tt][0], p1 = p0 + g[tt][1], p2 = p1 + g[tt][2], p3 = p2 + g[tt][3];
        const float x1 = __shfl_up(p3, 16), x2 = __shfl_up(p3, 32), x3 = __shfl_up(p3, 48);
        const float excl = (fq >= 1 ? x1 : 0.f) + (fq >= 2 ? x2 : 0.f) + (fq >= 3 ? x3 : 0.f);
        const float ttot = __shfl(excl + p3, 48 + fr);
        const float off = base + excl;
        c[tt][0] = off + p0; c[tt][1] = off + p1; c[tt][2] = off + p2; c[tt][3] = off + p3;
        base += ttot;
    }
    const float total = base;
    if (dir) {
#pragma unroll
        for (int tt = 0; tt < 4; ++tt)
#pragma unroll
            for (int i = 0; i < 4; ++i) c[tt][i] = total - c[tt][i] + g[tt][i];
    }
    if (G1) {
        LAS bf16* KS = (LAS bf16*)(lds + (dir ? GL_A1 : GL_A0));
#pragma unroll
        for (int tt = 0; tt < 4; ++tt) {
            float e[4];
#pragma unroll
            for (int i = 0; i < 4; ++i) e[i] = __uint_as_float((unsigned)R.kr[tt][i] << 16) * __expf(total - c[tt][i]);
            *(LAS v2u*)(KS + (jt * 16 + fr) * GL_STR + tt * 16 + fq * 4) = (v2u){pk2(e[0], e[1]), pk2(e[2], e[3])};
        }
        if (fq == 0) decay[((size_t)(dir * 8 + bh) * 128 + n) * 64 + jt * 16 + fr] = __expf(total);
    } else {
        LAS bf16* Qd = (LAS bf16*)(lds + (dir ? GL_A2 : GL_A0)); LAS bf16* Kd = (LAS bf16*)(lds + (dir ? GL_A3 : GL_A1));
#pragma unroll
        for (int tt = 0; tt < 4; ++tt)
#pragma unroll
            for (int i = 0; i < 4; ++i) {
                const int t = tt * 16 + fq * 4 + i;
                const float q = __uint_as_float((unsigned)R.qr[tt][i] << 16) * 0.125f, k = __uint_as_float((unsigned)R.kr[tt][i] << 16);
                const unsigned w = pk2(q * __expf(c[tt][i]), k * __expf(-c[tt][i]));
                Qd[t * GL_STR + jt * 16 + fr] = (bf16)(w & 0xffffu); Kd[t * GL_STR + jt * 16 + fr] = (bf16)(w >> 16);
            }
    }
    LAS bf16* VTl = (LAS bf16*)(lds + GL_VT);
#pragma unroll
    for (int j = 0; j < 2; ++j) {
        const int cc = tid + 512 * j, t = cc & 63, dvc = cc >> 6;
        const v4u raw = R.vraw[j];
        LAS bf16* dst = VTl + (dvc * 8) * GL_STR + t;
#pragma unroll
        for (int i = 0; i < 8; ++i) dst[i * GL_STR] = (bf16)((i & 1) ? (raw[i >> 1] >> 16) : (raw[i >> 1] & 0xffffu));
    }
}

__device__ __forceinline__ void gla_g1(LAS unsigned char* lds, const float* z, const bf16* proj, const float* gfw, const float* gfb, const float* gbw, const float* gbb,
                                       float* decay, bf16* ST, const float* conv_w, const float* conv_b, bf16* mix, int G, int bid, int tid, int wave, int lane) {
    const int fr = lane & 15, fq = lane >> 4;
    GlaIn R;
    if (bid < 1024) gla_front_load(R, z, proj, gfw, gfb, gbw, gbb, (bid >> 7) >> 2, (bid >> 7) & 3, bid & 127, tid, wave, lane);
    for (int it = bid; it < 1024; it += G) {
        const int bh = it >> 7, n = it & 127, b = bh >> 2, h = bh & 3;
        const int cc0 = h * 128 + (tid & 15) * 8;
        v4u cbg[2], ccg[2][3], cxv[2][3];
#pragma unroll
        for (int i = 0; i < 2; ++i) {
            const int t = b * SEQ + n * 64 + (tid >> 4) + 32 * i;
            const bf16* row = proj + (size_t)t * NPROJ;
            cbg[i] = *(const v4u*)(row + 1536 + cc0); ccg[i][1] = *(const v4u*)(row + 2048 + cc0); cxv[i][1] = *(const v4u*)(row + 2560 + cc0);
            const bool hp = (t & (SEQ - 1)) != 0, hn = (t & (SEQ - 1)) != SEQ - 1;
            ccg[i][0] = (v4u){0, 0, 0, 0}; cxv[i][0] = (v4u){0, 0, 0, 0}; ccg[i][2] = (v4u){0, 0, 0, 0}; cxv[i][2] = (v4u){0, 0, 0, 0};
            if (hp) { ccg[i][0] = *(const v4u*)(row - NPROJ + 2048 + cc0); cxv[i][0] = *(const v4u*)(row - NPROJ + 2560 + cc0); }
            if (hn) { ccg[i][2] = *(const v4u*)(row + NPROJ + 2048 + cc0); cxv[i][2] = *(const v4u*)(row + NPROJ + 2560 + cc0); }
        }
        gla_front_compute<true>(R, lds, decay, b, h, n, tid, wave, lane);
        { const int nx = it + G; if (nx < 1024) gla_front_load(R, z, proj, gfw, gfb, gbw, gbb, (nx >> 7) >> 2, (nx >> 7) & 3, nx & 127, tid, wave, lane); }
        {
            f32x4 w0[2], w1[2], w2[2], cb[2];
#pragma unroll
            for (int q = 0; q < 2; ++q) { w0[q] = *(const f32x4*)(conv_w + cc0 + 4 * q); w1[q] = *(const f32x4*)(conv_w + 512 + cc0 + 4 * q); w2[q] = *(const f32x4*)(conv_w + 1024 + cc0 + 4 * q); cb[q] = *(const f32x4*)(conv_b + cc0 + 4 * q); }
#pragma unroll
            for (int i = 0; i < 2; ++i) {
                const int t = b * SEQ + n * 64 + (tid >> 4) + 32 * i;
                float o[8];
#pragma unroll
                for (int e = 0; e < 8; ++e) {
                    const int w = e >> 1; const bool hi = e & 1;
                    const float up = (hi ? bfhi(ccg[i][0][w]) : bflo(ccg[i][0][w])) * (hi ? bfhi(cxv[i][0][w]) : bflo(cxv[i][0][w]));
                    const float uc = (hi ? bfhi(ccg[i][1][w]) : bflo(ccg[i][1][w])) * (hi ? bfhi(cxv[i][1][w]) : bflo(cxv[i][1][w]));
                    const float un = (hi ? bfhi(ccg[i][2][w]) : bflo(ccg[i][2][w])) * (hi ? bfhi(cxv[i][2][w]) : bflo(cxv[i][2][w]));
                    const float g = hi ? bfhi(cbg[i][w]) : bflo(cbg[i][w]);
                    o[e] = g * (w0[e >> 2][e & 3] * up + w1[e >> 2][e & 3] * uc + w2[e >> 2][e & 3] * un + cb[e >> 2][e & 3]);
                }
                *(v4u*)(mix + (size_t)t * DM + 512 + cc0) = (v4u){pk2(o[0], o[1]), pk2(o[2], o[3]), pk2(o[4], o[5]), pk2(o[6], o[7])};
            }
        }
        __syncthreads();
        const LAS bf16* VTl = (const LAS bf16*)(lds + GL_VT);
        bf16x8 vb[2];
#pragma unroll
        for (int ks = 0; ks < 2; ++ks) vb[ks] = *(const LAS bf16x8*)(VTl + (wave * 16 + fr) * GL_STR + ks * 32 + fq * 8);
#pragma unroll
        for (int dir = 0; dir < 2; ++dir) {
            const LAS bf16* KS = (const LAS bf16*)(lds + (dir ? GL_A1 : GL_A0));
            unsigned w[4][2];
#pragma unroll
            for (int nt = 0; nt < 4; ++nt) {
                f32x4 acc = {0.f, 0.f, 0.f, 0.f};
#pragma unroll
                for (int ks = 0; ks < 2; ++ks) { const bf16x8 ka = *(const LAS bf16x8*)(KS + (nt * 16 + fr) * GL_STR + ks * 32 + fq * 8); acc = MFMA16(ka, vb[ks], acc); }
                w[nt][0] = pk2(acc[0], acc[1]); w[nt][1] = pk2(acc[2], acc[3]);
            }
#pragma unroll
            for (int k = 0; k < 4; k += 2) {
                const auto r0 = __builtin_amdgcn_permlane16_swap(w[k][0], w[k + 1][0], false, false);
                const auto r1 = __builtin_amdgcn_permlane16_swap(w[k][1], w[k + 1][1], false, false);
                *(v4u*)(ST + ((size_t)(dir * 8 + bh) * 128 + n) * 8192 + (wave * 16 + fr) * 64 + (k + (fq & 1)) * 16 + (fq >> 1) * 8) = (v4u){(unsigned)r0[0], (unsigned)r1[0], (unsigned)r0[1], (unsigned)r1[1]};
            }
        }
        __syncthreads();
    }
}

__device__ __forceinline__ void gla_g2(bf16* ST, const float* decay, int G, int bid, int tid) {
    for (int e = bid * 512 + tid; e < 16 * 8192; e += G * 512) {
        const int chain = e >> 13, el = e & 8191, j = el & 63, dir = chain >> 3;
        bf16* base = ST + (size_t)chain * 128 * 8192 + el; const float* dec = decay + (size_t)chain * 128 * 64 + j;
        float S = 0.f;
        for (int s0 = 0; s0 < 128; s0 += 64) {
            float tmp[64], d[64];
#pragma unroll
            for (int u = 0; u < 64; ++u) { const int n = dir ? 127 - (s0 + u) : s0 + u; tmp[u] = __uint_as_float((unsigned)base[(size_t)n * 8192] << 16); d[u] = dec[n * 64]; }
#pragma unroll
            for (int u = 0; u < 64; ++u) { const int n = dir ? 127 - (s0 + u) : s0 + u; base[(size_t)n * 8192] = (bf16)(pk2(S, 0.f) & 0xffffu); S = d[u] * S + tmp[u]; }
        }
    }
}

__device__ __forceinline__ void gla_g3(LAS unsigned char* lds, const float* z, const bf16* proj, const float* gfw, const float* gfb, const float* gbw, const float* gbb,
                                       const bf16* ST, const float* gla_norm, bf16* mix, int G, int bid, int tid, int wave, int lane) {
    const int fr = lane & 15, fq = lane >> 4, tt = wave & 3, dh = wave >> 2;
    GlaIn R;
    if (bid < 1024) gla_front_load(R, z, proj, gfw, gfb, gbw, gbb, (bid >> 7) >> 2, (bid >> 7) & 3, bid & 127, tid, wave, lane);
    for (int it = bid; it < 1024; it += G) {
        const int bh = it >> 7, n = it & 127, b = bh >> 2, h = bh & 3;
        bf16x8 stf[2][4][2]; v2u rr4[4];
#pragma unroll
        for (int dir = 0; dir < 2; ++dir)
#pragma unroll
            for (int dt = 0; dt < 4; ++dt)
#pragma unroll
                for (int ks = 0; ks < 2; ++ks) stf[dir][dt][ks] = *(const bf16x8*)(ST + ((size_t)(dir * 8 + bh) * 128 + n) * 8192 + (size_t)((dh * 4 + dt) * 16 + fr) * 64 + ks * 32 + fq * 8);
#pragma unroll
        for (int dt = 0; dt < 4; ++dt) rr4[dt] = *(const v2u*)(proj + (size_t)(b * SEQ + n * 64 + tt * 16 + fr) * NPROJ + 1024 + h * 128 + (dh * 4 + dt) * 16 + fq * 4);
        gla_front_compute<false>(R, lds, nullptr, b, h, n, tid, wave, lane);
        __syncthreads();
        { const int nx = it + G; if (nx < 1024) gla_front_load(R, z, proj, gfw, gfb, gbw, gbb, (nx >> 7) >> 2, (nx >> 7) & 3, nx & 127, tid, wave, lane); }
        const LAS bf16* VTl = (const LAS bf16*)(lds + GL_VT);
        f32x4 o[4];
#pragma unroll
        for (int dt = 0; dt < 4; ++dt) o[dt] = (f32x4){0.f, 0.f, 0.f, 0.f};
#pragma unroll
        for (int dir = 0; dir < 2; ++dir) {
            const LAS bf16* Qd = (const LAS bf16*)(lds + (dir ? GL_A2 : GL_A0));
            const LAS bf16* Kd = (const LAS bf16*)(lds + (dir ? GL_A3 : GL_A1));
            bf16x8 qfr[2];
#pragma unroll
            for (int ks = 0; ks < 2; ++ks) qfr[ks] = *(const LAS bf16x8*)(Qd + (tt * 16 + fr) * GL_STR + ks * 32 + fq * 8);
            f32x4 at[4];
#pragma unroll
            for (int mt = 0; mt < 4; ++mt) {
                f32x4 a = {0.f, 0.f, 0.f, 0.f};
                const bool live = dir ? (mt >= tt) : (mt <= tt);
                if (live) {
#pragma unroll
                    for (int ks = 0; ks < 2; ++ks) { const bf16x8 kfr = *(const LAS bf16x8*)(Kd + (mt * 16 + fr) * GL_STR + ks * 32 + fq * 8); a = MFMA16(kfr, qfr[ks], a); }
                    if (mt == tt) {
#pragma unroll
                        for (int i = 0; i < 4; ++i) { const int m = fq * 4 + i; const bool keep = dir ? (m >= fr) : (m <= fr); a[i] = keep ? a[i] : 0.f; }
                    }
                }
                at[mt] = a;
            }
            bf16x8 pa[2];
#pragma unroll
            for (int s2 = 0; s2 < 2; ++s2) pa[s2] = mk8(pk2(at[2 * s2][0], at[2 * s2][1]), pk2(at[2 * s2][2], at[2 * s2][3]), pk2(at[2 * s2 + 1][0], at[2 * s2 + 1][1]), pk2(at[2 * s2 + 1][2], at[2 * s2 + 1][3]));
#pragma unroll
            for (int dt = 0; dt < 4; ++dt) {
                const int dvrow = (dh * 4 + dt) * 16 + fr;
#pragma unroll
                for (int s2 = 0; s2 < 2; ++s2) {
                    const v2u lo = *(const LAS v2u*)(VTl + dvrow * GL_STR + s2 * 32 + fq * 4), hi = *(const LAS v2u*)(VTl + dvrow * GL_STR + s2 * 32 + 16 + fq * 4);
                    o[dt] = MFMA16(mk8(lo.x, lo.y, hi.x, hi.y), pa[s2], o[dt]);
                }
#pragma unroll
                for (int ks = 0; ks < 2; ++ks) {
                    o[dt] = MFMA16(stf[dir][dt][ks], qfr[ks], o[dt]);
                }
            }
        }
        float ss = 0.f;
#pragma unroll
        for (int dt = 0; dt < 4; ++dt) ss += (o[dt][0] * o[dt][0] + o[dt][1] * o[dt][1]) + (o[dt][2] * o[dt][2] + o[dt][3] * o[dt][3]);
        ss += __shfl_xor(ss, 16); ss += __shfl_xor(ss, 32);
        LAS float* SS = (LAS float*)(lds + GL_SS);
        if (fq == 0) SS[dh * 64 + tt * 16 + fr] = ss;
        __syncthreads();
        const float tot = SS[tt * 16 + fr] + SS[64 + tt * 16 + fr];
        const float rs = rsqrtf(tot * (1.f / 128.f) + EPS);
        const int tok = b * SEQ + n * 64 + tt * 16 + fr;
#pragma unroll
        for (int dt = 0; dt < 4; ++dt) {
            const int c = h * 128 + (dh * 4 + dt) * 16 + fq * 4;
            const v2u rr = rr4[dt];
            const f32x4 gn = *(const f32x4*)(gla_norm + c);
            const float v0 = o[dt][0] * rs * gn[0] * silu_f(bflo(rr.x)), v1 = o[dt][1] * rs * gn[1] * silu_f(bfhi(rr.x));
            const float v2 = o[dt][2] * rs * gn[2] * silu_f(bflo(rr.y)), v3 = o[dt][3] * rs * gn[3] * silu_f(bfhi(rr.y));
            *(v2u*)(mix + (size_t)tok * DM + c) = (v2u){pk2(v0, v1), pk2(v2, v3)};
        }
    }
}

typedef float f32x16 __attribute__((ext_vector_type(16)));
#define MFMA32(a, b, c) __builtin_amdgcn_mfma_f32_32x32x16_bf16((a), (b), (c), 0, 0, 0)
template <int RS>
__device__ __forceinline__ void xattn_stage(LAS unsigned char* lds, const bf16* src, int tid) {
    const unsigned char* g = (const unsigned char*)src + (size_t)tid * 16;
    LAS unsigned char* wb = lds + (tid >> 5) * RS + (tid & 31) * 16;
#pragma unroll
    for (int hb = 0; hb < 2; ++hb) {
        v4u r[8];
#pragma unroll
        for (int i = 0; i < 8; ++i) r[i] = *(const v4u*)(g + (hb * 8 + i) * 8192);
#pragma unroll
        for (int i = 0; i < 8; ++i) *(LAS v4u*)(wb + (hb * 8 + i) * 16 * RS) = r[i];
        asm volatile("" ::: "memory");
    }
}
__device__ __forceinline__ void xattn_unit(LAS unsigned char* lds, const bf16* QO, bf16* OO, const bf16* Kmem, const bf16* VT, int bh, int qt, int tid, int wave, int lane) {
    const int l31 = lane & 31, hh = lane >> 5, b = bh >> 2, h = bh & 3;
    const int row = b * SEQ + qt * 256 + wave * 32 + l31;
    xattn_stage<528>(lds, Kmem + (size_t)bh * 65536, tid);
    bf16x8 qf[16];
#pragma unroll
    for (int ks = 0; ks < 16; ++ks) qf[ks] = *(const bf16x8*)(QO + (size_t)row * DM + h * 256 + ks * 16 + hh * 8);
    __syncthreads();
    f32x16 st[8];
#pragma unroll
    for (int kt = 0; kt < 8; ++kt) {
        f32x16 a;
#pragma unroll
        for (int i = 0; i < 16; ++i) a[i] = 0.f;
        const LAS unsigned char* kp = lds + (kt * 32 + l31) * 528 + hh * 16;
        __builtin_amdgcn_s_setprio(1);
#pragma unroll
        for (int ks = 0; ks < 16; ++ks) a = MFMA32(*(const LAS bf16x8*)(kp + ks * 32), qf[ks], a);
        __builtin_amdgcn_s_setprio(0);
        st[kt] = a;
        asm volatile("" ::: "memory");
    }
    float mx = -3.0e38f;
#pragma unroll
    for (int kt = 0; kt < 8; ++kt)
#pragma unroll
        for (int i = 0; i < 16; ++i) mx = fmaxf(mx, st[kt][i]);
    mx = fmaxf(mx, __shfl_xor(mx, 32));
    float l = 0.f;
    bf16x8 pb[8][2];
#pragma unroll
    for (int kt = 0; kt < 8; ++kt)
#pragma unroll
        for (int s2 = 0; s2 < 2; ++s2) {
            float pv[8];
#pragma unroll
            for (int j = 0; j < 8; ++j) { pv[j] = __builtin_amdgcn_exp2f(st[kt][8 * s2 + j] - mx); l += pv[j]; }
            pb[kt][s2] = mk8(pk2(pv[0], pv[1]), pk2(pv[2], pv[3]), pk2(pv[4], pv[5]), pk2(pv[6], pv[7]));
        }
    l += __shfl_xor(l, 32);
    const float inv = 1.f / l;
    __syncthreads();
    xattn_stage<520>(lds, VT + (size_t)bh * 65536, tid);
    __syncthreads();
    bf16* orow = OO + (size_t)row * DM + h * 256;
#pragma unroll 1
    for (int dt = 0; dt < 8; ++dt) {
        f32x16 a;
#pragma unroll
        for (int i = 0; i < 16; ++i) a[i] = 0.f;
        const LAS unsigned char* vp = lds + (dt * 32 + l31) * 520 + hh * 8;
        __builtin_amdgcn_s_setprio(1);
#pragma unroll
        for (int kt = 0; kt < 8; ++kt)
#pragma unroll
            for (int s2 = 0; s2 < 2; ++s2) {
                const v2u lo = *(const LAS v2u*)(vp + (kt * 32 + 16 * s2) * 2), hi = *(const LAS v2u*)(vp + (kt * 32 + 16 * s2 + 8) * 2);
                a = MFMA32(mk8(lo.x, lo.y, hi.x, hi.y), pb[kt][s2], a);
            }
        __builtin_amdgcn_s_setprio(0);
        unsigned w[4][2];
#pragma unroll
        for (int g = 0; g < 4; ++g) { w[g][0] = pk2(a[4 * g] * inv, a[4 * g + 1] * inv); w[g][1] = pk2(a[4 * g + 2] * inv, a[4 * g + 3] * inv); }
#pragma unroll
        for (int k = 0; k < 4; k += 2) {
            const auto r0 = __builtin_amdgcn_permlane32_swap(w[k][0], w[k + 1][0], false, false);
            const auto r1 = __builtin_amdgcn_permlane32_swap(w[k][1], w[k + 1][1], false, false);
            *(v4u*)(orow + dt * 32 + 8 * k + 8 * hh) = (v4u){(unsigned)r0[0], (unsigned)r1[0], (unsigned)r0[1], (unsigned)r1[1]};
        }
    }
    __syncthreads();
}
__device__ __forceinline__ void xattn_phase(LAS unsigned char* lds, const bf16* QO, bf16* OO, const bf16* Kmem, const bf16* VT, int G, int bid, int tid, int wave, int lane) {
    for (int u = bid; u < 256; u += G) xattn_unit(lds, QO, OO, Kmem, VT, u >> 5, u & 31, tid, wave, lane);
}

#define RLX_AGENT __ATOMIC_RELAXED, __HIP_MEMORY_SCOPE_AGENT
#define XB_TMO      128
#define XB_XCNT(j)  (256  + 64 * (j))
#define XB_XSUB(j)  (1280 + 64 * (j))
#define XB_XGEN(j)  (2304 + 64 * (j))
#define XB_TOP      3328
#define XB_TOPGEN   3392
#define XCD_BAR_WORDS 3456
#define XB_SPIN_CAP (1u << 18)

__device__ __forceinline__ unsigned xb_ld(unsigned* p)              { return __hip_atomic_load(p, __ATOMIC_RELAXED, __HIP_MEMORY_SCOPE_AGENT); }
__device__ __forceinline__ unsigned xb_add(unsigned* p, unsigned v) { return __hip_atomic_fetch_add(p, v, __ATOMIC_RELAXED, __HIP_MEMORY_SCOPE_AGENT); }
__device__ __forceinline__ unsigned xb_xcc_id() { return (unsigned)__builtin_amdgcn_s_getreg((3 << 11) | 20) & 0xFu; }
#define XB_SPIN(cond, bar) do { unsigned _sp = 0; while (cond) { __builtin_amdgcn_s_sleep(1); \
    if ((++_sp & 255u) == 0u) { if (xb_ld(&(bar)[XB_TMO])) break; if (_sp > XB_SPIN_CAP) { atomicAdd(&(bar)[XB_TMO], 1u); break; } } } } while (0)

struct XcdBarrier {
    unsigned* bar; unsigned x;
    volatile LAS unsigned* st;
};

__device__ __forceinline__ XcdBarrier xcd_barrier_post(unsigned* bar, volatile LAS unsigned* st) {
    XcdBarrier b; b.bar = bar; b.x = xb_xcc_id(); b.st = st;
    if (threadIdx.x == 0) (void)xb_add(&bar[XB_XCNT(b.x)], 1u);
    return b;
}
__device__ __forceinline__ void xcd_barrier_complete(unsigned* bar, unsigned x, unsigned& nloc, unsigned& nx) {
    const unsigned G = gridDim.x * gridDim.y * gridDim.z;
    unsigned sum, cnt, mine, sp = 0u;
    for (;;) {
        sum = 0u; cnt = 0u; mine = 0u;
#pragma unroll
        for (unsigned j = 0; j < 16; ++j) { const unsigned c = xb_ld(&bar[XB_XCNT(j)]); sum += c; cnt += (c > 0u) ? 1u : 0u; mine = (j == x) ? c : mine; }
        if (sum == G) break;
        __builtin_amdgcn_s_sleep(1);
        if ((++sp & 255u) == 0u) { if (xb_ld(&bar[XB_TMO])) break; if (sp > XB_SPIN_CAP) { atomicAdd(&bar[XB_TMO], 1u); break; } }
    }
    nloc = mine > 0u ? mine : 1u; nx = cnt > 0u ? cnt : 1u;
}

__device__ __forceinline__ void xcd_barrier(const XcdBarrier& b) {
    asm volatile("s_waitcnt vmcnt(0)" ::: "memory");
    __syncthreads();
    if (threadIdx.x == 0) {
        unsigned* bar = b.bar;
        __builtin_amdgcn_s_waitcnt(0);
        unsigned nloc = b.st[0], nx = b.st[1];
        if (nloc == 0u) { xcd_barrier_complete(bar, b.x, nloc, nx); b.st[0] = nloc; b.st[1] = nx; }
        const unsigned old = xb_add(&bar[XB_XSUB(b.x)], 1u);
        const unsigned gen = old / nloc;
        if (old + 1u == (gen + 1u) * nloc) {
            __builtin_amdgcn_fence(__ATOMIC_RELEASE, "agent");
            asm volatile("s_waitcnt vmcnt(0)" ::: "memory");
            const unsigned og = xb_add(&bar[XB_TOP], 1u);
            const unsigned tg = og / nx;
            if (og + 1u == (tg + 1u) * nx) xb_add(&bar[XB_TOPGEN], 1u);
            else XB_SPIN(xb_ld(&bar[XB_TOPGEN]) == tg, bar);
            __builtin_amdgcn_fence(__ATOMIC_ACQUIRE, "agent");
            xb_add(&bar[XB_XGEN(b.x)], 1u);
            asm volatile("s_waitcnt vmcnt(0)" ::: "memory");
        } else {
            XB_SPIN(xb_ld(&bar[XB_TOPGEN]) == gen, bar);
            __builtin_amdgcn_fence(__ATOMIC_ACQUIRE, "agent");
            asm volatile("s_waitcnt vmcnt(0)" ::: "memory");
        }
    }
    __syncthreads();
}

constexpr int I_UP = 16 * 44, I_KV = 16 * 32, I_DN = 44 * 16, I_IN = 16 * 97, I_SQ = 16 * 16;
constexpr int N_EARLY = 2 * I_UP + I_KV, N_LATE = I_DN + I_IN + 3 * I_SQ + 2 * I_UP + I_DN;
struct Params { const float* in[26]; float* out; unsigned char* ws; };


__global__ void __launch_bounds__(512) fwd_kernel(Params p) {
    extern __shared__ __attribute__((aligned(16))) unsigned char lds_raw[];
    LAS unsigned char* lds = (LAS unsigned char*)lds_raw;
#define FRESH_TID() int tid = threadIdx.x; asm volatile("" : "+v"(tid)); const int lane = tid & 63, wave = __builtin_amdgcn_readfirstlane(tid >> 6); (void)lane; (void)wave
    const int G = gridDim.x, bid = blockIdx.x;
    unsigned char* ws = p.ws;
    float* rowss = (float*)(ws + WS_ROWSS); float* zbuf = (float*)(ws + WS_Z); float* decay = (float*)(ws + WS_DECAY);
    bf16* W1CAT = (bf16*)(ws + WS_W1CAT); bf16* WD1 = (bf16*)(ws + WS_WD1); bf16* WIN = (bf16*)(ws + WS_WIN); bf16* WZ = (bf16*)(ws + WS_WZ);
    bf16* WOUT = (bf16*)(ws + WS_WOUT); bf16* WQ = (bf16*)(ws + WS_WQ); bf16* WO = (bf16*)(ws + WS_WO); bf16* W2CAT = (bf16*)(ws + WS_W2CAT); bf16* WD2 = (bf16*)(ws + WS_WD2);
    bf16* KMEM = (bf16*)(ws + WS_KMEM); bf16* VTM = (bf16*)(ws + WS_VT); bf16* MIX = (bf16*)(ws + WS_MIX); bf16* RB = (bf16*)(ws + WS_R); bf16* XG = (bf16*)(ws + WS_XG);
    bf16* ST = (bf16*)p.out;
    const float* x = p.in[0]; float* out = p.out;
    volatile LAS unsigned* MISC = (volatile LAS unsigned*)(lds + LDS_MISC);
    if (threadIdx.x < 16) MISC[threadIdx.x] = 0u;
    __syncthreads();
    const XcdBarrier xbar = xcd_barrier_post((unsigned*)(ws + WS_BAR), MISC);

    {
        FRESH_TID();
        LAS float* scr = (LAS float*)(lds + wave * 16896);
        const int gw = bid * 8 + wave, NGW = G * 8;
        for (int it = gw; it < N_EARLY; it += NGW) {
            int r = it;
            if (r < I_UP) { const int kb = r / 44, n0 = (r % 44) * 64; tr_tile<64>(p.in[3], DFF, DM, kb * 64, n0, W1CAT + (size_t)((n0 >> 7) * 256 + (n0 & 127)) * DM, scr, lane); continue; } r -= I_UP;
            if (r < I_UP) { const int kb = r / 44, n0 = (r % 44) * 64; tr_tile<64>(p.in[4], DFF, DM, kb * 64, n0, W1CAT + (size_t)((n0 >> 7) * 256 + 128 + (n0 & 127)) * DM, scr, lane); continue; } r -= I_UP;
            { const int kb = r / 32, n0 = (r % 32) * 64; tr_tile<64>(p.in[19], 2 * DM, DM, kb * 64, n0, W1CAT + (size_t)(2 * DFF + n0) * DM, scr, lane); }
        }
        for (int m = gw * 2; m < MTOK + BATCH * NMEM; m += NGW * 2) {
            if (m < MTOK) norm_rows2_bf16(x + (size_t)m * DM, x + (size_t)(m + 1) * DM, p.in[2], XG + (size_t)m * DM, XG + (size_t)(m + 1) * DM, lane);
            else norm_rows2_bf16(p.in[1] + (size_t)(m - MTOK) * DM, p.in[1] + (size_t)(m + 1 - MTOK) * DM, p.in[17], XG + (size_t)m * DM, XG + (size_t)(m + 1) * DM, lane);
        }
        for (int i = bid * 512 + tid; i < 3 * MTOK; i += G * 512) rowss[i] = 0.f;
    }
    xcd_barrier(xbar);

    {
        pg8::Gemm g{XG, W1CAT, MTOK + 512, 2 * DFF + 2 * DM, DM};
        OrderUpKV S; S.base.init(MTOK, 2 * DFF, G, bid); S.extra = 16;
        EpiUp E{RB, nullptr, KMEM, VTM, 2 * DFF / 256};
        pg8::gemm_phase<EpiUp, OrderUpKV, true, true>(lds, g, S, E);
        constexpr int NU = 2 * DFF / 256 * (MTOK / 256) + 16;
        const int rem = NU % G, nsp = rem ? G - rem : G, si = rem ? bid - rem : bid;
        if (si >= 0) {
            FRESH_TID();
            LAS float* scr = (LAS float*)(lds + wave * 16896);
            for (int it = si * 8 + wave; it < N_LATE; it += nsp * 8) {
                int r = it;
                if (r < I_DN) { const int kb = r / 16, n0 = (r % 16) * 64; tr_tile<64>(p.in[5], DM, DFF, kb * 64, n0, WD1 + (size_t)n0 * DFF, scr, lane); continue; } r -= I_DN;
                if (r < I_IN) { const int kb = r / 97, nb = r % 97, n0 = nb * 32;
                    bf16* dst = nb < 48 ? WIN + (size_t)n0 * DM : (nb == 48 ? WZ : WIN + (size_t)(n0 - 32) * DM);
                    tr_tile<32>(p.in[7], DIN, DM, kb * 64, n0, dst, scr, lane, p.in[6]); continue; } r -= I_IN;
                if (r < I_SQ) { const int kb = r / 16, n0 = (r % 16) * 64; tr_tile<64>(p.in[15], DM, DM, kb * 64, n0, WOUT + (size_t)n0 * DM, scr, lane); continue; } r -= I_SQ;
                if (r < I_SQ) { const int kb = r / 16, n0 = (r % 16) * 64; tr_tile<64>(p.in[18], DM, DM, kb * 64, n0, WQ + (size_t)n0 * DM, scr, lane, p.in[16]); continue; } r -= I_SQ;
                if (r < I_SQ) { const int kb = r / 16, n0 = (r % 16) * 64; tr_tile<64>(p.in[20], DM, DM, kb * 64, n0, WO + (size_t)n0 * DM, scr, lane); continue; } r -= I_SQ;
                if (r < I_UP) { const int kb = r / 44, n0 = (r % 44) * 64; tr_tile<64>(p.in[22], DFF, DM, kb * 64, n0, W2CAT + (size_t)((n0 >> 7) * 256 + (n0 & 127)) * DM, scr, lane, p.in[21]); continue; } r -= I_UP;
                if (r < I_UP) { const int kb = r / 44, n0 = (r % 44) * 64; tr_tile<64>(p.in[23], DFF, DM, kb * 64, n0, W2CAT + (size_t)((n0 >> 7) * 256 + 128 + (n0 & 127)) * DM, scr, lane, p.in[21]); continue; } r -= I_UP;
                { const int kb = r / 16, n0 = (r % 16) * 64; tr_tile<64>(p.in[24], DM, DFF, kb * 64, n0, WD2 + (size_t)n0 * DFF, scr, lane); }
            }
        }
    }
    xcd_barrier(xbar);
    {
        pg8::Gemm g{RB, WD1, MTOK, DM, DFF};
        pg8::StaticOrder S; S.init(MTOK, DM, G, bid);
        EpiResB E{x, XG, rowss, 0.5f};
        pg8::gemm_phase<EpiResB, pg8::StaticOrder, true, true>(lds, g, S, E);
    }
    xcd_barrier(xbar);
    {
        {
        pg8::Gemm g{XG, WIN, MTOK, NPROJ, DM};
        pg8::StaticOrder S; S.init(MTOK, NPROJ, G, bid);
        EpiScale E{RB, NPROJ, rowss, 1.f, true};
        pg8::gemm_phase<EpiScale, pg8::StaticOrder, true, true>(lds, g, S, E);
        }
        FRESH_TID();
        const int fr = lane & 15, fq = lane >> 4;
        for (int rb = bid; rb < MTOK / 64; rb += G) {
            const int row0 = rb * 64 + (wave >> 1) * 16, zc0 = (wave & 1) * 16;
            f32x4 acc0 = {0.f, 0.f, 0.f, 0.f}, acc1 = {0.f, 0.f, 0.f, 0.f};
            const float rsq = rowss[row0 + fr];
#pragma unroll 1
            for (int half = 0; half < 2; ++half) {
                v4u rg[12];
#pragma unroll
                for (int i = 0; i < 12; ++i) {
                    const int c = tid + 512 * i, row = c >> 6, c16 = c & 63;
                    const bf16* src = (row < 64 ? XG + (size_t)(rb * 64 + row) * DM : WZ + (size_t)(row - 64) * DM) + half * 512 + c16 * 8;
                    rg[i] = *(const v4u*)src;
                }
#pragma unroll
                for (int i = 0; i < 12; ++i) { const int c = tid + 512 * i; *(LAS v4u*)(lds + (c >> 6) * 1040 + (c & 63) * 16) = rg[i]; }
                __syncthreads();
                const LAS unsigned char* ap = lds + (64 + zc0 + fr) * 1040 + fq * 16; const LAS unsigned char* bp = lds + ((wave >> 1) * 16 + fr) * 1040 + fq * 16;
#pragma unroll
                for (int i = 0; i < 16; i += 2) {
                    acc0 = MFMA16(*(const LAS bf16x8*)(ap + i * 64), *(const LAS bf16x8*)(bp + i * 64), acc0);
                    acc1 = MFMA16(*(const LAS bf16x8*)(ap + (i + 1) * 64), *(const LAS bf16x8*)(bp + (i + 1) * 64), acc1);
                }
                __syncthreads();
            }
            const float rs = rsqrtf(rsq * (1.f / DM) + EPS);
            *(f32x4*)(zbuf + (size_t)(row0 + fr) * 32 + zc0 + fq * 4) = (acc0 + acc1) * rs;
        }
    }
    xcd_barrier(xbar);
    { FRESH_TID(); gla_g1(lds, zbuf, RB, p.in[8], p.in[9], p.in[10], p.in[11], decay, ST, p.in[13], p.in[14], MIX, G, bid, tid, wave, lane); }
    xcd_barrier(xbar);
    { FRESH_TID(); gla_g2(ST, decay, G, bid, tid); }
    xcd_barrier(xbar);
    { FRESH_TID(); gla_g3(lds, zbuf, RB, p.in[8], p.in[9], p.in[10], p.in[11], ST, p.in[12], MIX, G, bid, tid, wave, lane); }
    xcd_barrier(xbar);
    {
        pg8::Gemm g{MIX, WOUT, MTOK, DM, DM};
        pg8::StaticOrder S; S.init(MTOK, DM, G, bid);
        EpiResB E{nullptr, XG, rowss + MTOK, 1.f};
        pg8::gemm_phase<EpiResB, pg8::StaticOrder, true, true>(lds, g, S, E);
    }
    xcd_barrier(xbar);
    {
        pg8::Gemm g{XG, WQ, MTOK, DM, DM};
        pg8::StaticOrder S; S.init(MTOK, DM, G, bid);
        EpiScale E{MIX, DM, rowss + MTOK, 0.0625f * 1.4426950408889634f, false};
        pg8::gemm_phase<EpiScale, pg8::StaticOrder, true, true>(lds, g, S, E);
    }
    xcd_barrier(xbar);
    { FRESH_TID(); xattn_phase(lds, MIX, RB, KMEM, VTM, G, bid, tid, wave, lane); }
    xcd_barrier(xbar);
    {
        pg8::Gemm g{RB, WO, MTOK, DM, DM};
        pg8::StaticOrder S; S.init(MTOK, DM, G, bid);
        EpiResB E{nullptr, XG, rowss + 2 * MTOK, 1.f};
        pg8::gemm_phase<EpiResB, pg8::StaticOrder, true, true>(lds, g, S, E);
    }
    xcd_barrier(xbar);
    {
        pg8::Gemm g{XG, W2CAT, MTOK, 2 * DFF, DM};
        pg8::StaticOrder S; S.init(MTOK, 2 * DFF, G, bid);
        EpiUp E{RB, rowss + 2 * MTOK, nullptr, nullptr, 2 * DFF / 256};
        pg8::gemm_phase<EpiUp, pg8::StaticOrder, true, true>(lds, g, S, E);
    }
    xcd_barrier(xbar);
    if (G == MTOK / 256 * (DM / 256)) {
        pg8::Gemm g{RB, WD2, MTOK, DM, DFF};
        pg8::StaticOrder S; S.init(MTOK, DM, G, bid);
        EpiResNorm E{XG, out, p.in[25], 0.5f, (float*)(ws + WS_PART), (unsigned*)(ws + WS_BAR + 16384)};
        pg8::gemm_phase<EpiResNorm, pg8::StaticOrder, false, true>(lds, g, S, E);
    } else {
        {
            pg8::Gemm g{RB, WD2, MTOK, DM, DFF};
            pg8::StaticOrder S; S.init(MTOK, DM, G, bid);
            EpiResF E{XG, out, 0.5f};
            pg8::gemm_phase<EpiResF, pg8::StaticOrder, true, true>(lds, g, S, E);
        }
        xcd_barrier(xbar);
        {
            FRESH_TID();
            const int gw = bid * 8 + wave, NGW = G * 8;
            for (int m = gw; m < MTOK; m += NGW) {
                f32x4* xr = (f32x4*)(out + (size_t)m * DM) + lane; const f32x4* gr = (const f32x4*)p.in[25] + lane;
                f32x4 v[4]; float s = 0.f;
#pragma unroll
                for (int j = 0; j < 4; ++j) { v[j] = xr[64 * j]; s += (v[j][0] * v[j][0] + v[j][1] * v[j][1]) + (v[j][2] * v[j][2] + v[j][3] * v[j][3]); }
                const float rs = rsqrtf(wave_sum(s) * (1.f / DM) + EPS);
#pragma unroll
                for (int j = 0; j < 4; ++j) xr[64 * j] = v[j] * rs * gr[64 * j];
            }
        }
    }
}

extern "C" void kernel_launch(void* const* d_in, const int* in_sizes, int n_in, void* d_out, int out_size, void* d_ws, size_t ws_size, hipStream_t stream) {
    static int grid_blocks = 0;
    if (!grid_blocks) {
        if (n_in != 26 || out_size != MTOK * DM || ws_size < WS_END) { fprintf(stderr, "kernel_launch: unexpected shapes n_in=%d out=%d ws=%zu\n", n_in, out_size, ws_size); grid_blocks = -1; return; }
        int dev = 0, cus = 0, per_cu = 0;
        hipGetDevice(&dev);
        hipDeviceGetAttribute(&cus, hipDeviceAttributeMultiprocessorCount, dev);
        hipFuncSetAttribute((const void*)fwd_kernel, hipFuncAttributeMaxDynamicSharedMemorySize, LDS_BYTES);
        hipOccupancyMaxActiveBlocksPerMultiprocessor(&per_cu, (const void*)fwd_kernel, 512, LDS_BYTES);
        if (per_cu < 1) { fprintf(stderr, "kernel_launch: occupancy query says %d blocks/CU\n", per_cu); per_cu = 1; }
        grid_blocks = cus * per_cu;
    }
    if (grid_blocks < 0) return;
    if (hipMemsetAsync((char*)d_ws + WS_BAR, 0, 32768, stream) != hipSuccess) { fprintf(stderr, "kernel_launch: memset failed\n"); return; }
    Params p{};
    for (int i = 0; i < 26; ++i) p.in[i] = (const float*)d_in[i];
    p.out = (float*)d_out; p.ws = (unsigned char*)d_ws;
    void* args[] = {&p};
    hipError_t e = hipLaunchCooperativeKernel((const void*)fwd_kernel, dim3(grid_blocks), dim3(512), args, LDS_BYTES, stream);
    if (e != hipSuccess) fprintf(stderr, "cooperative launch failed: %s (grid %d)\n", hipGetErrorString(e), grid_blocks);
}
```

```cpp
#include <hip/hip_runtime.h>
#include <cstdio>
#include <cstdint>
namespace pg8 {
#define PG8_LAS __attribute__((address_space(3)))
typedef unsigned short bf16_t;
typedef short bf16x8 __attribute__((ext_vector_type(8)));
typedef float f32x4 __attribute__((ext_vector_type(4)));
typedef unsigned u32x4 __attribute__((ext_vector_type(4)));
constexpr int BM = 256, BK = 64, HALF = 128, HTB = HALF * BK * 2  , STAGE_BYTES = 8 * HTB, NXCD = 8, WGM = 8;

__host__ __device__ __forceinline__ int lds_byte(int r, int c) { const int st = (r >> 4) * 2 + (c >> 5), rr = r & 15, cc = c & 31, ob = rr * 64 + cc * 2; return st * 1024 + (ob ^ (((ob >> 9) & 1) << 5)); }
__host__ __device__ __forceinline__ void stage_rc(int b, int& R, int& C) { const int st = b / 1024, sb = b % 1024, swz = sb ^ (((sb >> 9) & 1) << 5); R = (st >> 1) * 16 + swz / 64; C = (st & 1) * 32 + (swz % 64) / 2; }
__host__ __device__ __forceinline__ int perm32(int rho) { const int n = rho >> 4, i = rho & 15; return 8 * (i >> 2) + 4 * n + (i & 3); }

struct Unit { int pm, pn; };
struct Gemm { const bf16_t* A; const bf16_t* Bt; int M, N, K; };

struct StaticOrder {
    int nM, nN, nwg, G, c;
    __host__ __device__ void init(int M, int N, int G_, int c_) { nM = M / BM; nN = N / BM; nwg = nM * nN; G = G_; c = c_; }
    __host__ __device__ bool next(int i, Unit& u) const {
        const long L = (long)i * G + c; if (L >= nwg) return false;
        int wgid = (int)L; { const int q = nwg / NXCD, r = nwg % NXCD, xcd = wgid % NXCD, off = wgid / NXCD; wgid = (xcd < r ? xcd * (q + 1) : r * (q + 1) + (xcd - r) * q) + off; }
        const int nig = WGM * nN, gid = wgid / nig, fm = gid * WGM, gsz = (nM - fm) < WGM ? (nM - fm) : WGM;
        u.pm = fm + ((wgid % nig) % gsz); u.pn = (wgid % nig) / gsz; return true;
    }
    __device__ __forceinline__ void a_ready(const Unit&) const {}
    __device__ __forceinline__ void done(const Unit&) const {}
};

__device__ __forceinline__ unsigned cvt_pk_bf16(float lo, float hi) { unsigned r; asm volatile("v_cvt_pk_bf16_f32 %0, %1, %2" : "=v"(r) : "v"(lo), "v"(hi)); return r; }
template <class Epi, class Sched, bool ALIGN_EPI = false, bool SP2 = false>
__device__ __forceinline__ void gemm_phase(PG8_LAS unsigned char* lds, const Gemm g, const Sched& S, const Epi& E) {
    int tid_l = threadIdx.x; asm volatile("" : "+v"(tid_l));
    const int tid = tid_l, wid = __builtin_amdgcn_readfirstlane(tid >> 6), lane = tid & 63, wr = wid >> 2, wc = wid & 3, fr = lane & 15, fq = lane >> 4;
    const int K = g.K, nt = K / BK;
    unsigned voffA[2], voffB[2];
#pragma unroll
    for (int i = 0; i < 2; ++i) { int R, C; stage_rc(tid * 16 + i * 8192, R, C); const int Rb = Epi::PERM ? ((R & ~31) + perm32(R & 31)) : R;
        voffA[i] = (unsigned)(R * K + C) * 2u; voffB[i] = (unsigned)(Rb * K + C) * 2u; }
    const size_t kstep = (size_t)(BK * 2);
    const size_t hstep = (size_t)HALF * K * 2;
    const size_t tstep = 2 * hstep;
    const unsigned ldsw = (unsigned)wid * 1024u;
    const int aoff = lds_byte(wr * 64 + fr, fq * 8), boff = lds_byte(wc * 32 + fr, fq * 8);
#define PG8_SA(b, h) (((b) * 2 + (h)) * HTB)
#define PG8_SB(b, h) ((4 + (b) * 2 + (h)) * HTB)
#define PG8_STAGE(bufoff, gbase, voff) do { _Pragma("unroll") for (int _i = 0; _i < 2; ++_i) \
        __builtin_amdgcn_global_load_lds((const unsigned*)((const char*)(gbase) + (voff)[_i]), (PG8_LAS unsigned*)(lds + (bufoff) + ldsw + _i * 8192), 16, 0, 0); } while (0)
#define PG8_LDA(dst, b, h) do { _Pragma("unroll") for (int m = 0; m < 4; ++m) _Pragma("unroll") for (int k = 0; k < 2; ++k) dst[m][k] = *(const PG8_LAS bf16x8*)(lds + PG8_SA(b, h) + aoff + m * 2048 + k * 1024); } while (0)
#define PG8_LDB(dst, b, h) do { _Pragma("unroll") for (int n = 0; n < 2; ++n) _Pragma("unroll") for (int k = 0; k < 2; ++k) dst[n][k] = *(const PG8_LAS bf16x8*)(lds + PG8_SB(b, h) + boff + n * 2048 + k * 1024); } while (0)
#define PG8_MMA(ai, bj, At, Bt) do { __builtin_amdgcn_s_setprio(1); _Pragma("unroll") for (int m = 0; m < 4; ++m) _Pragma("unroll") for (int n = 0; n < 2; ++n) _Pragma("unroll") for (int k = 0; k < 2; ++k) \
        acc[ai][bj][m][n] = __builtin_amdgcn_mfma_f32_16x16x32_bf16(Bt[n][k], At[m][k], acc[ai][bj][m][n], 0, 0, 0); __builtin_amdgcn_s_setprio(0); } while (0)
#define PG8_WAIT_V(n) asm volatile("s_waitcnt vmcnt(" #n ")" ::: "memory")
#define PG8_WAIT_L(n) asm volatile("s_waitcnt lgkmcnt(" #n ")" ::: "memory")
#define PG8_BAR __builtin_amdgcn_s_barrier()
#define PG8_SCHED __builtin_amdgcn_sched_barrier(0)
    Unit cur, nxt; int ui = 0;
    if (!S.next(0, cur)) return;
    f32x4 acc[2][2][4][2];
#pragma unroll
    for (int a = 0; a < 2; ++a)
#pragma unroll
        for (int b = 0; b < 2; ++b)
#pragma unroll
            for (int m = 0; m < 4; ++m)
#pragma unroll
                for (int n = 0; n < 2; ++n) acc[a][b][m][n] = (f32x4){0.f, 0.f, 0.f, 0.f};
    bf16x8 At[4][2], B0[2][2], B1[2][2];
    const char* cA = (const char*)g.A + (size_t)cur.pm * tstep; const char* cB = (const char*)g.Bt + (size_t)cur.pn * tstep;
    S.a_ready(cur);
    if constexpr (SP2) {
        PG8_STAGE(PG8_SB(0, 0), cB, voffB); PG8_STAGE(PG8_SB(0, 1), cB + hstep, voffB); PG8_STAGE(PG8_SA(0, 0), cA, voffA); PG8_STAGE(PG8_SA(0, 1), cA + hstep, voffA);
        if (wr == 1) PG8_BAR;
        PG8_WAIT_V(2); PG8_BAR;
        PG8_STAGE(PG8_SB(1, 0), cB + kstep, voffB); PG8_STAGE(PG8_SA(1, 0), cA + kstep, voffA); PG8_STAGE(PG8_SB(1, 1), cB + hstep + kstep, voffB);
        PG8_WAIT_V(6); PG8_BAR;
    } else {
        PG8_STAGE(PG8_SB(0, 0), cB, voffB); PG8_STAGE(PG8_SA(0, 0), cA, voffA); PG8_STAGE(PG8_SB(0, 1), cB + hstep, voffB); PG8_STAGE(PG8_SA(0, 1), cA + hstep, voffA);
        if (wr == 1) PG8_BAR;
        PG8_WAIT_V(4); PG8_BAR;
        PG8_STAGE(PG8_SB(1, 0), cB + kstep, voffB); PG8_STAGE(PG8_SA(1, 0), cA + kstep, voffA); PG8_STAGE(PG8_SB(1, 1), cB + hstep + kstep, voffB);
        PG8_WAIT_V(6); PG8_BAR;
    }
    for (;;) {
        const bool has_next = S.next(ui + 1, nxt);
        const char* nA = has_next ? (const char*)g.A + (size_t)nxt.pm * tstep : cA; const char* nB = has_next ? (const char*)g.Bt + (size_t)nxt.pn * tstep : cB;
        for (int t = 0; t < nt; t += 2) {
            const bool last = (t == nt - 2);
            const char* a1 = cA + (size_t)(t + 1) * kstep;
            const char* a2 = last ? nA : cA + (size_t)(t + 2) * kstep; const char* b2 = last ? nB : cB + (size_t)(t + 2) * kstep;
            const char* a3 = a2 + kstep; const char* b3 = b2 + kstep;
            if (last && has_next) S.a_ready(nxt);
            if constexpr (SP2) {
            PG8_LDB(B0, 0, 0); PG8_LDB(B1, 0, 1); PG8_SCHED; PG8_LDA(At, 0, 0); PG8_STAGE(PG8_SA(1, 1), a1 + hstep, voffA);
            PG8_WAIT_V(8); PG8_WAIT_L(0); PG8_BAR; PG8_MMA(0, 0, At, B0); PG8_MMA(0, 1, At, B1); PG8_BAR; PG8_SCHED;
            PG8_LDA(At, 0, 1); PG8_STAGE(PG8_SB(0, 0), b2, voffB); PG8_STAGE(PG8_SB(0, 1), b2 + hstep, voffB); PG8_STAGE(PG8_SA(0, 0), a2, voffA);
            PG8_WAIT_V(8); PG8_WAIT_L(0); PG8_BAR; PG8_MMA(1, 0, At, B0); PG8_MMA(1, 1, At, B1); PG8_BAR; PG8_SCHED;
            PG8_LDB(B0, 1, 0); PG8_LDB(B1, 1, 1); PG8_SCHED; PG8_LDA(At, 1, 0); PG8_STAGE(PG8_SA(0, 1), a2 + hstep, voffA);
            PG8_WAIT_V(8); PG8_WAIT_L(0); PG8_BAR; PG8_MMA(0, 0, At, B0); PG8_MMA(0, 1, At, B1); PG8_BAR; PG8_SCHED;
            PG8_LDA(At, 1, 1); PG8_STAGE(PG8_SB(1, 0), b3, voffB); PG8_STAGE(PG8_SB(1, 1), b3 + hstep, voffB); PG8_STAGE(PG8_SA(1, 0), a3, voffA);
            PG8_WAIT_V(8); PG8_WAIT_L(0); PG8_BAR; PG8_MMA(1, 0, At, B0); PG8_MMA(1, 1, At, B1); PG8_BAR; PG8_SCHED;
            } else {
            PG8_LDB(B0, 0, 0); PG8_SCHED; PG8_LDA(At, 0, 0); PG8_STAGE(PG8_SA(1, 1), a1 + hstep, voffA);
            PG8_WAIT_L(8); PG8_BAR; PG8_WAIT_L(0); PG8_MMA(0, 0, At, B0); PG8_BAR; PG8_SCHED;
            PG8_LDB(B1, 0, 1); PG8_STAGE(PG8_SB(0, 0), b2, voffB);
            PG8_BAR; PG8_WAIT_L(0); PG8_MMA(0, 1, At, B1); PG8_BAR;
            PG8_LDA(At, 0, 1); PG8_STAGE(PG8_SA(0, 0), a2, voffA);
            PG8_BAR; PG8_WAIT_L(0); PG8_MMA(1, 0, At, B0); PG8_BAR; PG8_SCHED;
            PG8_STAGE(PG8_SB(0, 1), b2 + hstep, voffB);
            PG8_WAIT_V(6); PG8_BAR; PG8_MMA(1, 1, At, B1); PG8_BAR;
            PG8_LDB(B0, 1, 0); PG8_SCHED; PG8_LDA(At, 1, 0); PG8_STAGE(PG8_SA(0, 1), a2 + hstep, voffA);
            PG8_WAIT_L(8); PG8_BAR; PG8_WAIT_L(0); PG8_MMA(0, 0, At, B0); PG8_BAR; PG8_SCHED;
            PG8_LDB(B1, 1, 1); PG8_STAGE(PG8_SB(1, 0), b3, voffB);
            PG8_BAR; PG8_WAIT_L(0); PG8_MMA(0, 1, At, B1); PG8_BAR;
            PG8_LDA(At, 1, 1); PG8_STAGE(PG8_SA(1, 0), a3, voffA);
            PG8_BAR; PG8_WAIT_L(0); PG8_MMA(1, 0, At, B0); PG8_BAR; PG8_SCHED;
            PG8_STAGE(PG8_SB(1, 1), b3 + hstep, voffB);
            PG8_WAIT_V(6); PG8_BAR; PG8_MMA(1, 1, At, B1); PG8_BAR;
            }
        }
        if constexpr (ALIGN_EPI) { if (wr == 0) PG8_BAR; }
        if constexpr (!Epi::AFTER_DRAIN) { E(acc, cur, wr, wc, fr, fq); S.done(cur); }
        if (!has_next) break;
#pragma unroll
        for (int a = 0; a < 2; ++a)
#pragma unroll
            for (int b = 0; b < 2; ++b)
#pragma unroll
                for (int m = 0; m < 4; ++m)
#pragma unroll
                    for (int n = 0; n < 2; ++n) acc[a][b][m][n] = (f32x4){0.f, 0.f, 0.f, 0.f};
        cur = nxt; cA = nA; cB = nB; ++ui;
        if constexpr (ALIGN_EPI) { if (wr == 1) PG8_BAR; }
    }
    PG8_WAIT_V(0);
    if constexpr (!ALIGN_EPI) { if (wr == 0) PG8_BAR; }
    PG8_BAR;
    if constexpr (Epi::AFTER_DRAIN) { E.fused(acc, cur, wr, wc, fr, fq, lds, wid, lane); S.done(cur); }
#undef PG8_SA
#undef PG8_SB
#undef PG8_STAGE
#undef PG8_LDA
#undef PG8_LDB
#undef PG8_MMA
#undef PG8_WAIT_V
#undef PG8_WAIT_L
#undef PG8_BAR
#undef PG8_SCHED
}
}

constexpr int DM = 1024, BATCH = 2, SEQ = 8192, MTOK = BATCH * SEQ, NMEM = 256, DFF = 2816, DIN = 3104, NPROJ = 3072;
constexpr float EPS = 1e-6f;
constexpr size_t MiB = 1u << 20;
constexpr size_t WS_ROWSS = 0;
constexpr size_t WS_Z = 1 * MiB;
constexpr size_t WS_DECAY = 3 * MiB;
constexpr size_t WS_W1CAT = 4 * MiB;
constexpr size_t WS_WD1 = 19 * MiB;
constexpr size_t WS_WIN = 25 * MiB;
constexpr size_t WS_WZ = 31 * MiB;
constexpr size_t WS_WOUT = 32 * MiB, WS_WQ = 34 * MiB, WS_WO = 36 * MiB;
constexpr size_t WS_W2CAT = 38 * MiB;
constexpr size_t WS_WD2 = 49 * MiB;
constexpr size_t WS_KMEM = 55 * MiB;
constexpr size_t WS_VT = 56 * MiB;
constexpr size_t WS_MIX = 58 * MiB;
constexpr size_t WS_R = 90 * MiB;
constexpr size_t WS_XG = 186 * MiB;
constexpr size_t WS_ST = 186 * MiB;
constexpr size_t WS_END = 256 * MiB;
constexpr size_t WS_PART = 256 * 1024;
constexpr size_t WS_BAR = 768 * 1024;
constexpr int LDS_MISC = 135168;
constexpr int LDS_BYTES = LDS_MISC + 64;

#define LAS __attribute__((address_space(3)))
typedef unsigned short bf16;
typedef unsigned v4u __attribute__((ext_vector_type(4)));
typedef unsigned v2u __attribute__((ext_vector_type(2)));
typedef float f32x4 __attribute__((ext_vector_type(4)));
typedef short bf16x8 __attribute__((ext_vector_type(8)));
#define LDS_WAIT() asm volatile("s_waitcnt lgkmcnt(0)" ::: "memory")

typedef float f32x2v __attribute__((ext_vector_type(2)));
typedef __bf16 bf16x2v __attribute__((ext_vector_type(2)));
__device__ __forceinline__ unsigned pk2(float lo, float hi) { const f32x2v v = {lo, hi}; const bf16x2v b = __builtin_convertvector(v, bf16x2v); return __builtin_bit_cast(unsigned, b); }
__device__ __forceinline__ float bflo(unsigned w) { return __uint_as_float(w << 16); }
__device__ __forceinline__ float bfhi(unsigned w) { return __uint_as_float(w & 0xffff0000u); }
__device__ __forceinline__ float silu_f(float x) { return x * __builtin_amdgcn_rcpf(1.f + __expf(-x)); }
__device__ __forceinline__ float logsig_f(float a) { return fminf(a, 0.f) - __logf(1.f + __expf(-fabsf(a))); }
__device__ __forceinline__ float wave_sum(float v) {
#pragma unroll
    for (int o = 1; o < 64; o <<= 1) v += __shfl_xor(v, o);
    return v;
}
__device__ __forceinline__ bf16x8 mk8(unsigned a, unsigned b, unsigned c, unsigned d) { v4u w = {a, b, c, d}; return __builtin_bit_cast(bf16x8, w); }
#define MFMA16(a, b, c) __builtin_amdgcn_mfma_f32_16x16x32_bf16((a), (b), (c), 0, 0, 0)

struct EpiUp {
    static constexpr bool PERM = true, AFTER_DRAIN = false;
    bf16* act; const float* rowss; bf16* Kmem; bf16* VT; int npn_main;
    __device__ __forceinline__ void operator()(const pg8::f32x4 (&acc)[2][2][4][2], const pg8::Unit& u, int wr, int wc, int fr, int fq) const {
        if (u.pn < npn_main) {
            const int row0 = u.pm * 256 + wr * 64 + fr, col0 = u.pn * 128 + wc * 32 + 8 * fq;
            float rsv[2][4];
#pragma unroll
            for (int ai = 0; ai < 2; ++ai)
#pragma unroll
                for (int m = 0; m < 4; ++m) rsv[ai][m] = rowss ? rowss[row0 + ai * 128 + m * 16] : 0.f;
#pragma unroll
            for (int ai = 0; ai < 2; ++ai)
#pragma unroll
                for (int m = 0; m < 4; ++m) {
                    const int r = row0 + ai * 128 + m * 16;
                    const float rs = rowss ? rsqrtf(rsv[ai][m] * (1.f / DM) + EPS) : 1.f;
                    float o[8];
#pragma unroll
                    for (int n = 0; n < 2; ++n)
#pragma unroll
                        for (int i = 0; i < 4; ++i) { const float g = acc[ai][0][m][n][i] * rs, uu = acc[ai][1][m][n][i] * rs; o[n * 4 + i] = silu_f(g) * uu; }
                    v4u w = {pk2(o[0], o[1]), pk2(o[2], o[3]), pk2(o[4], o[5]), pk2(o[6], o[7])};
                    *(v4u*)(act + (size_t)r * DFF + col0) = w;
                }
        } else {
            const int hsel = u.pn - npn_main;
            const int mt0 = (u.pm - MTOK / 256) * 256 + wr * 64 + fr;
#pragma unroll
            for (int ai = 0; ai < 2; ++ai)
#pragma unroll
                for (int m = 0; m < 4; ++m) {
                    const int mt = mt0 + ai * 128 + m * 16, b = mt >> 8, key = mt & 255;
#pragma unroll
                    for (int bj = 0; bj < 2; ++bj) {
                        const int d0 = bj * 128 + wc * 32 + 8 * fq;
                        const f32x4 v0 = acc[ai][bj][m][0], v1 = acc[ai][bj][m][1];
                        if (hsel < 4) {
                            v4u w = {pk2(v0[0], v0[1]), pk2(v0[2], v0[3]), pk2(v1[0], v1[1]), pk2(v1[2], v1[3])};
                            *(v4u*)(Kmem + ((size_t)((b * 4 + hsel) * 256 + key)) * 256 + d0) = w;
                        } else {
                            bf16* dst = VT + ((size_t)((b * 4 + hsel - 4) * 256 + d0)) * 256 + key;
                            const unsigned w0 = pk2(v0[0], v0[1]), w1 = pk2(v0[2], v0[3]), w2 = pk2(v1[0], v1[1]), w3 = pk2(v1[2], v1[3]);
                            dst[0 * 256] = (bf16)(w0 & 0xffffu); dst[1 * 256] = (bf16)(w0 >> 16); dst[2 * 256] = (bf16)(w1 & 0xffffu); dst[3 * 256] = (bf16)(w1 >> 16);
                            dst[4 * 256] = (bf16)(w2 & 0xffffu); dst[5 * 256] = (bf16)(w2 >> 16); dst[6 * 256] = (bf16)(w3 & 0xffffu); dst[7 * 256] = (bf16)(w3 >> 16);
                        }
                    }
                }
        }
    }
};
struct EpiResF {
    static constexpr bool PERM = false, AFTER_DRAIN = false;
    const bf16* base; float* out; float alpha;
    __device__ __forceinline__ void operator()(const pg8::f32x4 (&acc)[2][2][4][2], const pg8::Unit& u, int wr, int wc, int fr, int fq) const {
        const int row0 = u.pm * 256 + wr * 64 + fr, col0 = u.pn * 256 + wc * 32 + 4 * fq;
#pragma unroll
        for (int ai = 0; ai < 2; ++ai)
#pragma unroll
            for (int m = 0; m < 4; ++m) {
                const size_t off = (size_t)(row0 + ai * 128 + m * 16) * DM + col0;
#pragma unroll
                for (int bj = 0; bj < 2; ++bj)
#pragma unroll
                    for (int n = 0; n < 2; ++n) {
                        const v2u bw = *(const v2u*)(base + off + bj * 128 + n * 16);
                        const f32x4 bs = {bflo(bw.x), bfhi(bw.x), bflo(bw.y), bfhi(bw.y)};
                        *(f32x4*)(out + off + bj * 128 + n * 16) = bs + acc[ai][bj][m][n] * alpha;
                    }
            }
    }
};
struct EpiResB {
    static constexpr bool PERM = true, AFTER_DRAIN = false;
    const float* basef; bf16* xs; float* rowss; float alpha;
    __device__ __forceinline__ void operator()(const pg8::f32x4 (&acc)[2][2][4][2], const pg8::Unit& u, int wr, int wc, int fr, int fq) const {
        const int row0 = u.pm * 256 + wr * 64 + fr, col0 = u.pn * 256 + wc * 32 + 8 * fq;
#pragma unroll
        for (int ai = 0; ai < 2; ++ai) {
            f32x4 b0[4][2], b1[4][2];
            if (basef) {
#pragma unroll
                for (int m = 0; m < 4; ++m)
#pragma unroll
                    for (int bj = 0; bj < 2; ++bj) { const float* bp = basef + (size_t)(row0 + ai * 128 + m * 16) * DM + col0 + bj * 128; b0[m][bj] = __builtin_nontemporal_load((const f32x4*)bp); b1[m][bj] = __builtin_nontemporal_load((const f32x4*)(bp + 4));     }
            } else {
                v4u bw[4][2];
#pragma unroll
                for (int m = 0; m < 4; ++m)
#pragma unroll
                    for (int bj = 0; bj < 2; ++bj) bw[m][bj] = *(const v4u*)(xs + (size_t)(row0 + ai * 128 + m * 16) * DM + col0 + bj * 128);
#pragma unroll
                for (int m = 0; m < 4; ++m)
#pragma unroll
                    for (int bj = 0; bj < 2; ++bj) { const v4u w = bw[m][bj]; b0[m][bj] = (f32x4){bflo(w.x), bfhi(w.x), bflo(w.y), bfhi(w.y)}; b1[m][bj] = (f32x4){bflo(w.z), bfhi(w.z), bflo(w.w), bfhi(w.w)}; }
            }
#pragma unroll
            for (int m = 0; m < 4; ++m) {
                const int r = row0 + ai * 128 + m * 16; const size_t off = (size_t)r * DM + col0; float ss = 0.f;
#pragma unroll
                for (int bj = 0; bj < 2; ++bj) {
                    const f32x4 v0 = b0[m][bj] + acc[ai][bj][m][0] * alpha, v1 = b1[m][bj] + acc[ai][bj][m][1] * alpha;
                    ss += ((v0[0] * v0[0] + v0[1] * v0[1]) + (v0[2] * v0[2] + v0[3] * v0[3])) + ((v1[0] * v1[0] + v1[1] * v1[1]) + (v1[2] * v1[2] + v1[3] * v1[3]));
                    *(v4u*)(xs + off + bj * 128) = (v4u){pk2(v0[0], v0[1]), pk2(v0[2], v0[3]), pk2(v1[0], v1[1]), pk2(v1[2], v1[3])};
                }
                ss += __shfl_xor(ss, 16); ss += __shfl_xor(ss, 32); if (fq == 0) atomicAdd(rowss + r, ss);
            }
        }
    }
};
struct EpiScale {
    static constexpr bool PERM = true, AFTER_DRAIN = false;
    bf16* O; int ldc; const float* rowss; float scale; bool nt;
    __device__ __forceinline__ void operator()(const pg8::f32x4 (&acc)[2][2][4][2], const pg8::Unit& u, int wr, int wc, int fr, int fq) const {
        const int row0 = u.pm * 256 + wr * 64 + fr, col0 = u.pn * 256 + wc * 32 + 8 * fq;
        float rsv[2][4];
#pragma unroll
        for (int ai = 0; ai < 2; ++ai)
#pragma unroll
            for (int m = 0; m < 4; ++m) rsv[ai][m] = rowss[row0 + ai * 128 + m * 16];
#pragma unroll
        for (int ai = 0; ai < 2; ++ai)
#pragma unroll
            for (int m = 0; m < 4; ++m) {
                const int r = row0 + ai * 128 + m * 16;
                const float rs = rsqrtf(rsv[ai][m] * (1.f / DM) + EPS) * scale;
#pragma unroll
                for (int bj = 0; bj < 2; ++bj) {
                    const f32x4 v0 = acc[ai][bj][m][0] * rs, v1 = acc[ai][bj][m][1] * rs;
                    v4u w = {pk2(v0[0], v0[1]), pk2(v0[2], v0[3]), pk2(v1[0], v1[1]), pk2(v1[2], v1[3])};
                    if (nt) __builtin_nontemporal_store(w, (v4u*)(O + (size_t)r * ldc + col0 + bj * 128)); else *(v4u*)(O + (size_t)r * ldc + col0 + bj * 128) = w;
                }
            }
    }
};
struct EpiResNorm {
    static constexpr bool PERM = false, AFTER_DRAIN = true;
    const bf16* base; float* out; const float* gain; float alpha; float* part; unsigned* cnt;
    __device__ __forceinline__ void fused(pg8::f32x4 (&acc)[2][2][4][2], const pg8::Unit& u, int wr, int wc, int fr, int fq, PG8_LAS unsigned char* lds, int wid, int lane) const {
        const int row0 = u.pm * 256 + wr * 64 + fr, col0 = u.pn * 256 + wc * 32 + 4 * fq;
        LAS float* P = (LAS float*)lds;
        LAS float* S = (LAS float*)(lds + 4096);
#pragma unroll
        for (int ai = 0; ai < 2; ++ai) {
            v2u bw[4][2][2];
#pragma unroll
            for (int m = 0; m < 4; ++m)
#pragma unroll
                for (int bj = 0; bj < 2; ++bj)
#pragma unroll
                    for (int n = 0; n < 2; ++n) bw[m][bj][n] = *(const v2u*)(base + (size_t)(row0 + ai * 128 + m * 16) * DM + col0 + bj * 128 + n * 16);
#pragma unroll
            for (int m = 0; m < 4; ++m) {
                float ss = 0.f;
#pragma unroll
                for (int bj = 0; bj < 2; ++bj)
#pragma unroll
                    for (int n = 0; n < 2; ++n) {
                        const v2u w = bw[m][bj][n];
                        const f32x4 bs = {bflo(w.x), bfhi(w.x), bflo(w.y), bfhi(w.y)};
                        const f32x4 v = bs + acc[ai][bj][m][n] * alpha;
                        acc[ai][bj][m][n] = v;
                        ss += (v[0] * v[0] + v[1] * v[1]) + (v[2] * v[2] + v[3] * v[3]);
                    }
                ss += __shfl_xor(ss, 16); ss += __shfl_xor(ss, 32);
                if (fq == 0) P[(ai * 128 + wr * 64 + m * 16 + fr) * 4 + wc] = ss;
            }
        }
        __syncthreads();
        const int tid = wid * 64 + lane;
        if (tid < 256) {
            const float t = (P[tid * 4] + P[tid * 4 + 1]) + (P[tid * 4 + 2] + P[tid * 4 + 3]);
            __hip_atomic_store(part + (size_t)(u.pm * 256 + tid) * 4 + u.pn, t, __ATOMIC_RELAXED, __HIP_MEMORY_SCOPE_AGENT);
        }
        asm volatile("s_waitcnt vmcnt(0)" ::: "memory");
        __syncthreads();
        if (tid == 0) {
            __hip_atomic_fetch_add(cnt + 64 * u.pm, 1u, __ATOMIC_RELEASE, __HIP_MEMORY_SCOPE_AGENT);
            unsigned sp = 0;
            while (__hip_atomic_load(cnt + 64 * u.pm, __ATOMIC_RELAXED, __HIP_MEMORY_SCOPE_AGENT) < 4u && ++sp < (1u << 22)) __builtin_amdgcn_s_sleep(2);
            __builtin_amdgcn_fence(__ATOMIC_ACQUIRE, "agent");
        }
        __syncthreads();
        if (tid < 256) {
            const float* pp = part + (size_t)(u.pm * 256 + tid) * 4;
            const float t = (__hip_atomic_load(pp, __ATOMIC_RELAXED, __HIP_MEMORY_SCOPE_AGENT) + __hip_atomic_load(pp + 1, __ATOMIC_RELAXED, __HIP_MEMORY_SCOPE_AGENT))
                          + (__hip_atomic_load(pp + 2, __ATOMIC_RELAXED, __HIP_MEMORY_SCOPE_AGENT) + __hip_atomic_load(pp + 3, __ATOMIC_RELAXED, __HIP_MEMORY_SCOPE_AGENT));
            S[tid] = rsqrtf(t * (1.f / DM) + EPS);
        }
        __syncthreads();
        f32x4 gv[2][2];
#pragma unroll
        for (int bj = 0; bj < 2; ++bj)
#pragma unroll
            for (int n = 0; n < 2; ++n) gv[bj][n] = *(const f32x4*)(gain + col0 + bj * 128 + n * 16);
#pragma unroll
        for (int ai = 0; ai < 2; ++ai)
#pragma unroll
            for (int m = 0; m < 4; ++m) {
                const int rl = ai * 128 + wr * 64 + m * 16 + fr; const float rs = S[rl]; const size_t off = (size_t)(u.pm * 256 + rl) * DM + col0;
#pragma unroll
                for (int bj = 0; bj < 2; ++bj)
#pragma unroll
                    for (int n = 0; n < 2; ++n) { f32x4 ov = acc[ai][bj][m][n] * rs * gv[bj][n];
                        *(f32x4*)(out + off + bj * 128 + n * 16) = ov; }
            }
    }
};
struct OrderUpKV {
    pg8::StaticOrder base; int extra;
    __device__ bool next(int i, pg8::Unit& u) const {
        long L = (long)i * base.G + base.c;
        if (L < base.nwg) return base.next(i, u);
        L -= base.nwg; if (L >= extra) return false;
        u.pm = MTOK / 256 + (int)(L / 8); u.pn = base.nN + (int)(L % 8); return true;
    }
    __device__ __forceinline__ void a_ready(const pg8::Unit&) const {}
    __device__ __forceinline__ void done(const pg8::Unit&) const {}
};

template <int NW>
__device__ __forceinline__ void tr_tile(const float* __restrict__ W, int N, int K, int k0, int n0, bf16* orow0, LAS float* scr, int lane, const float* gain = nullptr) {
    constexpr int LPR = NW / 4, RPI = 64 / LPR, NI = 64 / RPI, STR = NW + 1, NO = NW * 8 / 64;
    const int kr = lane / LPR, nc = (lane % LPR) * 4;
    f32x4 v[NI];
#pragma unroll
    for (int i = 0; i < NI; ++i) v[i] = __builtin_nontemporal_load((const f32x4*)(W + (size_t)(k0 + i * RPI + kr) * N + n0 + nc));
    if (gain) {
#pragma unroll
        for (int i = 0; i < NI; ++i) v[i] = v[i] * gain[k0 + i * RPI + kr];
    }
#pragma unroll
    for (int i = 0; i < NI; ++i) { LAS float* d = scr + (i * RPI + kr) * STR + nc; d[0] = v[i][0]; d[1] = v[i][1]; d[2] = v[i][2]; d[3] = v[i][3]; }
    LDS_WAIT();
#pragma unroll
    for (int j = 0; j < NO; ++j) {
        const int idx = j * 64 + lane, c = idx & 7, n = idx >> 3; const LAS float* sp = scr + (8 * c) * STR + n;
        v4u o; o.x = pk2(sp[0 * STR], sp[1 * STR]); o.y = pk2(sp[2 * STR], sp[3 * STR]); o.z = pk2(sp[4 * STR], sp[5 * STR]); o.w = pk2(sp[6 * STR], sp[7 * STR]);
        *(v4u*)(orow0 + (size_t)n * K + k0 + 8 * c) = o;
    }
    LDS_WAIT();
}
__device__ __forceinline__ void norm_rows2_bf16(const float* x0, const float* x1, const float* gain, bf16* o0, bf16* o1, int lane) {
    const f32x4* xr0 = (const f32x4*)x0 + lane; const f32x4* xr1 = (const f32x4*)x1 + lane; const f32x4* gr = (const f32x4*)gain + lane;
    f32x4 v0[4], v1[4]; float s0 = 0.f, s1 = 0.f;
#pragma unroll
    for (int j = 0; j < 4; ++j) { v0[j] = __builtin_nontemporal_load(xr0 + 64 * j); v1[j] = __builtin_nontemporal_load(xr1 + 64 * j); }
#pragma unroll
    for (int j = 0; j < 4; ++j) { s0 += (v0[j][0] * v0[j][0] + v0[j][1] * v0[j][1]) + (v0[j][2] * v0[j][2] + v0[j][3] * v0[j][3]); s1 += (v1[j][0] * v1[j][0] + v1[j][1] * v1[j][1]) + (v1[j][2] * v1[j][2] + v1[j][3] * v1[j][3]); }
    const float r0 = rsqrtf(wave_sum(s0) * (1.f / DM) + EPS), r1 = rsqrtf(wave_sum(s1) * (1.f / DM) + EPS);
    v2u* p0 = (v2u*)o0 + lane; v2u* p1 = (v2u*)o1 + lane;
#pragma unroll
    for (int j = 0; j < 4; ++j) { const f32x4 gg = gr[64 * j]; const f32x4 t0 = v0[j] * r0 * gg, t1 = v1[j] * r1 * gg;
        p0[64 * j] = (v2u){pk2(t0[0], t0[1]), pk2(t0[2], t0[3])}; p1[64 * j] = (v2u){pk2(t1[0], t1[1]), pk2(t1[2], t1[3])}; }
}

constexpr int GL_STR = 72;
constexpr int GL_A0 = 0, GL_A1 = 9216, GL_A2 = 18432, GL_A3 = 27648, GL_VT = 36864, GL_SS = 36864 + 18432;

struct GlaIn { unsigned short qr[4][4], kr[4][4]; float bw[4]; float bias; f32x4 zv[4]; v4u vraw[2]; };
__device__ __forceinline__ void gla_front_load(GlaIn& R, const float* z, const bf16* proj, const float* gfw, const float* gfb, const float* gbw, const float* gbb,
                                               int b, int h, int n, int tid, int wave, int lane) {
    const int fr = lane & 15, fq = lane >> 4, jt = wave & 3, dir = wave >> 2;
    const int T0 = b * SEQ + n * 64, col = h * 64 + jt * 16 + fr;
    const float* gw = dir ? gbw : gfw; const float* gbias = dir ? gbb : gfb;
#pragma unroll
    for (int tt = 0; tt < 4; ++tt)
#pragma unroll
        for (int i = 0; i < 4; ++i) { const bf16* pr = proj + (size_t)(T0 + tt * 16 + fq * 4 + i) * NPROJ + col; R.qr[tt][i] = pr[0]; R.kr[tt][i] = pr[256]; }
#pragma unroll
    for (int ks = 0; ks < 4; ++ks) R.bw[ks] = gw[(fq * 4 + ks) * 256 + col];
    R.bias = gbias[col];
#pragma unroll
    for (int tt = 0; tt < 4; ++tt) R.zv[tt] = *(const f32x4*)(z + (size_t)(T0 + tt * 16 + fr) * 32 + dir * 16 + fq * 4);
#pragma unroll
    for (int i = 0; i < 2; ++i) { const int cc = tid + 512 * i; R.vraw[i] = *(const v4u*)(proj + (size_t)(T0 + (cc & 63)) * NPROJ + 512 + h * 128 + (cc >> 6) * 8); }
}
template <bool G1>
__device__ __forceinline__ void gla_front_compute(const GlaIn& R, LAS unsigned char* lds, float* decay, int b, int h, int n, int tid, int wave, int lane) {
    const int fr = lane & 15, fq = lane >> 4, jt = wave & 3, dir = wave >> 2, bh = b * 4 + h;
    float g[4][4], c[4][4];
#pragma unroll
    for (int tt = 0; tt < 4; ++tt) {
        f32x4 a = {R.bias, R.bias, R.bias, R.bias};
#pragma unroll
        for (int ks = 0; ks < 4; ++ks) a = __builtin_amdgcn_mfma_f32_16x16x4f32(R.zv[tt][ks], R.bw[ks], a, 0, 0, 0);
#pragma unroll
        for (int i = 0; i < 4; ++i) g[tt][i] = logsig_f(a[i]) * (1.f / 16.f);
    }
    float base = 0.f;
#pragma unroll
    for (int tt = 0; tt < 4; ++tt) {
        const float p0 = g[tt][0], p1 = p0 + g[tt][1], p2 = p1 + g[tt][2], p3 = p2 + g[tt][3];
        const float x1 = __shfl_up(p3, 16), x2 = __shfl_up(p3, 32), x3 = __shfl_up(p3, 48);
        const float excl = (fq >= 1 ? x1 : 0.f) + (fq >= 2 ? x2 : 0.f) + (fq >= 3 ? x3 : 0.f);
        const float ttot = __shfl(excl + p3, 48 + fr);
        const float off = base + excl;
        c[tt][0] = off + p0; c[tt][1] = off + p1; c[tt][2] = off + p2; c[tt][3] = off + p3;
        base += ttot;
    }
    const float total = base;
    if (dir) {
#pragma unroll
        for (int tt = 0; tt < 4; ++tt)
#pragma unroll
            for (int i = 0; i < 4; ++i) c[tt][i] = total - c[tt][i] + g[tt][i];
    }
    if (G1) {
        LAS bf16* KS = (LAS bf16*)(lds + (dir ? GL_A1 : GL_A0));
#pragma unroll
        for (int tt = 0; tt < 4; ++tt) {
            float e[4];
#pragma unroll
            for (int i = 0; i < 4; ++i) e[i] = __uint_as_float((unsigned)R.kr[tt][i] << 16) * __expf(total - c[tt][i]);
            *(LAS v2u*)(KS + (jt * 16 + fr) * GL_STR + tt * 16 + fq * 4) = (v2u){pk2(e[0], e[1]), pk2(e[2], e[3])};
        }
        if (fq == 0) decay[((size_t)(dir * 8 + bh) * 128 + n) * 64 + jt * 16 + fr] = __expf(total);
    } else {
        LAS bf16* Qd = (LAS bf16*)(lds + (dir ? GL_A2 : GL_A0)); LAS bf16* Kd = (LAS bf16*)(lds + (dir ? GL_A3 : GL_A1));
#pragma unroll
        for (int tt = 0; tt < 4; ++tt)
#pragma unroll
            for (int i = 0; i < 4; ++i) {
                const int t = tt * 16 + fq * 4 + i;
                const float q = __uint_as_float((unsigned)R.qr[tt][i] << 16) * 0.125f, k = __uint_as_float((unsigned)R.kr[tt][i] << 16);
                const unsigned w = pk2(q * __expf(c[tt][i]), k * __expf(-c[tt][i]));
                Qd[t * GL_STR + jt * 16 + fr] = (bf16)(w & 0xffffu); Kd[t * GL_STR + jt * 16 + fr] = (bf16)(w >> 16);
            }
    }
    LAS bf16* VTl = (LAS bf16*)(lds + GL_VT);
#pragma unroll
    for (int j = 0; j < 2; ++j) {
        const int cc = tid + 512 * j, t = cc & 63, dvc = cc >> 6;
        const v4u raw = R.vraw[j];
        LAS bf16* dst = VTl + (dvc * 8) * GL_STR + t;
#pragma unroll
        for (int i = 0; i < 8; ++i) dst[i * GL_STR] = (bf16)((i & 1) ? (raw[i >> 1] >> 16) : (raw[i >> 1] & 0xffffu));
    }
}

__device__ __forceinline__ void gla_g1(LAS unsigned char* lds, const float* z, const bf16* proj, const float* gfw, const float* gfb, const float* gbw, const float* gbb,
                                       float* decay, bf16* ST, const float* conv_w, const float* conv_b, bf16* mix, int G, int bid, int tid, int wave, int lane) {
    const int fr = lane & 15, fq = lane >> 4;
    GlaIn R;
    if (bid < 1024) gla_front_load(R, z, proj, gfw, gfb, gbw, gbb, (bid >> 7) >> 2, (bid >> 7) & 3, bid & 127, tid, wave, lane);
    for (int it = bid; it < 1024; it += G) {
        const int bh = it >> 7, n = it & 127, b = bh >> 2, h = bh & 3;
        const int cc0 = h * 128 + (tid & 15) * 8;
        v4u cbg[2], ccg[2][3], cxv[2][3];
#pragma unroll
        for (int i = 0; i < 2; ++i) {
            const int t = b * SEQ + n * 64 + (tid >> 4) + 32 * i;
            const bf16* row = proj + (size_t)t * NPROJ;
            cbg[i] = *(const v4u*)(row + 1536 + cc0); ccg[i][1] = *(const v4u*)(row + 2048 + cc0); cxv[i][1] = *(const v4u*)(row + 2560 + cc0);
            const bool hp = (t & (SEQ - 1)) != 0, hn = (t & (SEQ - 1)) != SEQ - 1;
            ccg[i][0] = (v4u){0, 0, 0, 0}; cxv[i][0] = (v4u){0, 0, 0, 0}; ccg[i][2] = (v4u){0, 0, 0, 0}; cxv[i][2] = (v4u){0, 0, 0, 0};
            if (hp) { ccg[i][0] = *(const v4u*)(row - NPROJ + 2048 + cc0); cxv[i][0] = *(const v4u*)(row - NPROJ + 2560 + cc0); }
            if (hn) { ccg[i][2] = *(const v4u*)(row + NPROJ + 2048 + cc0); cxv[i][2] = *(const v4u*)(row + NPROJ + 2560 + cc0); }
        }
        gla_front_compute<true>(R, lds, decay, b, h, n, tid, wave, lane);
        { const int nx = it + G; if (nx < 1024) gla_front_load(R, z, proj, gfw, gfb, gbw, gbb, (nx >> 7) >> 2, (nx >> 7) & 3, nx & 127, tid, wave, lane); }
        {
            f32x4 w0[2], w1[2], w2[2], cb[2];
#pragma unroll
            for (int q = 0; q < 2; ++q) { w0[q] = *(const f32x4*)(conv_w + cc0 + 4 * q); w1[q] = *(const f32x4*)(conv_w + 512 + cc0 + 4 * q); w2[q] = *(const f32x4*)(conv_w + 1024 + cc0 + 4 * q); cb[q] = *(const f32x4*)(conv_b + cc0 + 4 * q); }
#pragma unroll
            for (int i = 0; i < 2; ++i) {
                const int t = b * SEQ + n * 64 + (tid >> 4) + 32 * i;
                float o[8];
#pragma unroll
                for (int e = 0; e < 8; ++e) {
                    const int w = e >> 1; const bool hi = e & 1;
                    const float up = (hi ? bfhi(ccg[i][0][w]) : bflo(ccg[i][0][w])) * (hi ? bfhi(cxv[i][0][w]) : bflo(cxv[i][0][w]));
                    const float uc = (hi ? bfhi(ccg[i][1][w]) : bflo(ccg[i][1][w])) * (hi ? bfhi(cxv[i][1][w]) : bflo(cxv[i][1][w]));
                    const float un = (hi ? bfhi(ccg[i][2][w]) : bflo(ccg[i][2][w])) * (hi ? bfhi(cxv[i][2][w]) : bflo(cxv[i][2][w]));
                    const float g = hi ? bfhi(cbg[i][w]) : bflo(cbg[i][w]);
                    o[e] = g * (w0[e >> 2][e & 3] * up + w1[e >> 2][e & 3] * uc + w2[e >> 2][e & 3] * un + cb[e >> 2][e & 3]);
                }
                *(v4u*)(mix + (size_t)t * DM + 512 + cc0) = (v4u){pk2(o[0], o[1]), pk2(o[2], o[3]), pk2(o[4], o[5]), pk2(o[6], o[7])};
            }
        }
        __syncthreads();
        const LAS bf16* VTl = (const LAS bf16*)(lds + GL_VT);
        bf16x8 vb[2];
#pragma unroll
        for (int ks = 0; ks < 2; ++ks) vb[ks] = *(const LAS bf16x8*)(VTl + (wave * 16 + fr) * GL_STR + ks * 32 + fq * 8);
#pragma unroll
        for (int dir = 0; dir < 2; ++dir) {
            const LAS bf16* KS = (const LAS bf16*)(lds + (dir ? GL_A1 : GL_A0));
            unsigned w[4][2];
#pragma unroll
            for (int nt = 0; nt < 4; ++nt) {
                f32x4 acc = {0.f, 0.f, 0.f, 0.f};
#pragma unroll
                for (int ks = 0; ks < 2; ++ks) { const bf16x8 ka = *(const LAS bf16x8*)(KS + (nt * 16 + fr) * GL_STR + ks * 32 + fq * 8); acc = MFMA16(ka, vb[ks], acc); }
                w[nt][0] = pk2(acc[0], acc[1]); w[nt][1] = pk2(acc[2], acc[3]);
            }
#pragma unroll
            for (int k = 0; k < 4; k += 2) {
                const auto r0 = __builtin_amdgcn_permlane16_swap(w[k][0], w[k + 1][0], false, false);
                const auto r1 = __builtin_amdgcn_permlane16_swap(w[k][1], w[k + 1][1], false, false);
                *(v4u*)(ST + ((size_t)(dir * 8 + bh) * 128 + n) * 8192 + (wave * 16 + fr) * 64 + (k + (fq & 1)) * 16 + (fq >> 1) * 8) = (v4u){(unsigned)r0[0], (unsigned)r1[0], (unsigned)r0[1], (unsigned)r1[1]};
            }
        }
        __syncthreads();
    }
}

__device__ __forceinline__ void gla_g2(bf16* ST, const float* decay, int G, int bid, int tid) {
    for (int e = bid * 512 + tid; e < 16 * 8192; e += G * 512) {
        const int chain = e >> 13, el = e & 8191, j = el & 63, dir = chain >> 3;
        bf16* base = ST + (size_t)chain * 128 * 8192 + el; const float* dec = decay + (size_t)chain * 128 * 64 + j;
        float S = 0.f;
        for (int s0 = 0; s0 < 128; s0 += 64) {
            float tmp[64], d[64];
#pragma unroll
            for (int u = 0; u < 64; ++u) { const int n = dir ? 127 - (s0 + u) : s0 + u; tmp[u] = __uint_as_float((unsigned)base[(size_t)n * 8192] << 16); d[u] = dec[n * 64]; }
#pragma unroll
            for (int u = 0; u < 64; ++u) { const int n = dir ? 127 - (s0 + u) : s0 + u; base[(size_t)n * 8192] = (bf16)(pk2(S, 0.f) & 0xffffu); S = d[u] * S + tmp[u]; }
        }
    }
}

__device__ __forceinline__ void gla_g3(LAS unsigned char* lds, const float* z, const bf16* proj, const float* gfw, const float* gfb, const float* gbw, const float* gbb,
                                       const bf16* ST, const float* gla_norm, bf16* mix, int G, int bid, int tid, int wave, int lane) {
    const int fr = lane & 15, fq = lane >> 4, tt = wave & 3, dh = wave >> 2;
    GlaIn R;
    if (bid < 1024) gla_front_load(R, z, proj, gfw, gfb, gbw, gbb, (bid >> 7) >> 2, (bid >> 7) & 3, bid & 127, tid, wave, lane);
    for (int it = bid; it < 1024; it += G) {
        const int bh = it >> 7, n = it & 127, b = bh >> 2, h = bh & 3;
        bf16x8 stf[2][4][2]; v2u rr4[4];
#pragma unroll
        for (int dir = 0; dir < 2; ++dir)
#pragma unroll
            for (int dt = 0; dt < 4; ++dt)
#pragma unroll
                for (int ks = 0; ks < 2; ++ks) stf[dir][dt][ks] = *(const bf16x8*)(ST + ((size_t)(dir * 8 + bh) * 128 + n) * 8192 + (size_t)((dh * 4 + dt) * 16 + fr) * 64 + ks * 32 + fq * 8);
#pragma unroll
        for (int dt = 0; dt < 4; ++dt) rr4[dt] = *(const v2u*)(proj + (size_t)(b * SEQ + n * 64 + tt * 16 + fr) * NPROJ + 1024 + h * 128 + (dh * 4 + dt) * 16 + fq * 4);
        gla_front_compute<false>(R, lds, nullptr, b, h, n, tid, wave, lane);
        __syncthreads();
        { const int nx = it + G; if (nx < 1024) gla_front_load(R, z, proj, gfw, gfb, gbw, gbb, (nx >> 7) >> 2, (nx >> 7) & 3, nx & 127, tid, wave, lane); }
        const LAS bf16* VTl = (const LAS bf16*)(lds + GL_VT);
        f32x4 o[4];
#pragma unroll
        for (int dt = 0; dt < 4; ++dt) o[dt] = (f32x4){0.f, 0.f, 0.f, 0.f};
#pragma unroll
        for (int dir = 0; dir < 2; ++dir) {
            const LAS bf16* Qd = (const LAS bf16*)(lds + (dir ? GL_A2 : GL_A0));
            const LAS bf16* Kd = (const LAS bf16*)(lds + (dir ? GL_A3 : GL_A1));
            bf16x8 qfr[2];
#pragma unroll
            for (int ks = 0; ks < 2; ++ks) qfr[ks] = *(const LAS bf16x8*)(Qd + (tt * 16 + fr) * GL_STR + ks * 32 + fq * 8);
            f32x4 at[4];
#pragma unroll
            for (int mt = 0; mt < 4; ++mt) {
                f32x4 a = {0.f, 0.f, 0.f, 0.f};
                const bool live = dir ? (mt >= tt) : (mt <= tt);
                if (live) {
#pragma unroll
                    for (int ks = 0; ks < 2; ++ks) { const bf16x8 kfr = *(const LAS bf16x8*)(Kd + (mt * 16 + fr) * GL_STR + ks * 32 + fq * 8); a = MFMA16(kfr, qfr[ks], a); }
                    if (mt == tt) {
#pragma unroll
                        for (int i = 0; i < 4; ++i) { const int m = fq * 4 + i; const bool keep = dir ? (m >= fr) : (m <= fr); a[i] = keep ? a[i] : 0.f; }
                    }
                }
                at[mt] = a;
            }
            bf16x8 pa[2];
#pragma unroll
            for (int s2 = 0; s2 < 2; ++s2) pa[s2] = mk8(pk2(at[2 * s2][0], at[2 * s2][1]), pk2(at[2 * s2][2], at[2 * s2][3]), pk2(at[2 * s2 + 1][0], at[2 * s2 + 1][1]), pk2(at[2 * s2 + 1][2], at[2 * s2 + 1][3]));
#pragma unroll
            for (int dt = 0; dt < 4; ++dt) {
                const int dvrow = (dh * 4 + dt) * 16 + fr;
#pragma unroll
                for (int s2 = 0; s2 < 2; ++s2) {
                    const v2u lo = *(const LAS v2u*)(VTl + dvrow * GL_STR + s2 * 32 + fq * 4), hi = *(const LAS v2u*)(VTl + dvrow * GL_STR + s2 * 32 + 16 + fq * 4);
                    o[dt] = MFMA16(mk8(lo.x, lo.y, hi.x, hi.y), pa[s2], o[dt]);
                }
#pragma unroll
                for (int ks = 0; ks < 2; ++ks) {
                    o[dt] = MFMA16(stf[dir][dt][ks], qfr[ks], o[dt]);
                }
            }
        }
        float ss = 0.f;
#pragma unroll
        for (int dt = 0; dt < 4; ++dt) ss += (o[dt][0] * o[dt][0] + o[dt][1] * o[dt][1]) + (o[dt][2] * o[dt][2] + o[dt][3] * o[dt][3]);
        ss += __shfl_xor(ss, 16); ss += __shfl_xor(ss, 32);
        LAS float* SS = (LAS float*)(lds + GL_SS);
        if (fq == 0) SS[dh * 64 + tt * 16 + fr] = ss;
        __syncthreads();
        const float tot = SS[tt * 16 + fr] + SS[64 + tt * 16 + fr];
        const float rs = rsqrtf(tot * (1.f / 128.f) + EPS);
        const int tok = b * SEQ + n * 64 + tt * 16 + fr;
        unsigned wq[4][2];
#pragma unroll
        for (int dt = 0; dt < 4; ++dt) {
            const int c = h * 128 + (dh * 4 + dt) * 16 + fq * 4;
            const v2u rr = rr4[dt];
            const f32x4 gn = *(const f32x4*)(gla_norm + c);
            const float v0 = o[dt][0] * rs * gn[0] * silu_f(bflo(rr.x)), v1 = o[dt][1] * rs * gn[1] * silu_f(bfhi(rr.x));
            const float v2 = o[dt][2] * rs * gn[2] * silu_f(bflo(rr.y)), v3 = o[dt][3] * rs * gn[3] * silu_f(bfhi(rr.y));
            wq[dt][0] = pk2(v0, v1); wq[dt][1] = pk2(v2, v3);
        }
#pragma unroll
        for (int k = 0; k < 4; k += 2) {
            const auto r0 = __builtin_amdgcn_permlane16_swap(wq[k][0], wq[k + 1][0], false, false);
            const auto r1 = __builtin_amdgcn_permlane16_swap(wq[k][1], wq[k + 1][1], false, false);
            *(v4u*)(mix + (size_t)tok * DM + h * 128 + (dh * 4 + k + (fq & 1)) * 16 + (fq >> 1) * 8) = (v4u){(unsigned)r0[0], (unsigned)r1[0], (unsigned)r0[1], (unsigned)r1[1]};
        }
    }
}

typedef float f32x16 __attribute__((ext_vector_type(16)));
#define MFMA32(a, b, c) __builtin_amdgcn_mfma_f32_32x32x16_bf16((a), (b), (c), 0, 0, 0)
template <int RS>
__device__ __forceinline__ void xattn_stage(LAS unsigned char* lds, const bf16* src, int tid) {
    const unsigned char* g = (const unsigned char*)src + (size_t)tid * 16;
    LAS unsigned char* wb = lds + (tid >> 5) * RS + (tid & 31) * 16;
#pragma unroll
    for (int hb = 0; hb < 2; ++hb) {
        v4u r[8];
#pragma unroll
        for (int i = 0; i < 8; ++i) r[i] = *(const v4u*)(g + (hb * 8 + i) * 8192);
#pragma unroll
        for (int i = 0; i < 8; ++i) *(LAS v4u*)(wb + (hb * 8 + i) * 16 * RS) = r[i];
        asm volatile("" ::: "memory");
    }
}
__device__ __forceinline__ void xattn_unit(LAS unsigned char* lds, const bf16* QO, bf16* OO, const bf16* Kmem, const bf16* VT, int bh, int qt, int tid, int wave, int lane) {
    const int l31 = lane & 31, hh = lane >> 5, b = bh >> 2, h = bh & 3;
    const int row = b * SEQ + qt * 256 + wave * 32 + l31;
    xattn_stage<528>(lds, Kmem + (size_t)bh * 65536, tid);
    bf16x8 qf[16];
#pragma unroll
    for (int ks = 0; ks < 16; ++ks) qf[ks] = *(const bf16x8*)(QO + (size_t)row * DM + h * 256 + ks * 16 + hh * 8);
    __syncthreads();
    f32x16 st[8];
#pragma unroll
    for (int kt = 0; kt < 8; ++kt) {
        f32x16 a;
#pragma unroll
        for (int i = 0; i < 16; ++i) a[i] = 0.f;
        const LAS unsigned char* kp = lds + (kt * 32 + l31) * 528 + hh * 16;
        __builtin_amdgcn_s_setprio(1);
#pragma unroll
        for (int ks = 0; ks < 16; ++ks) a = MFMA32(*(const LAS bf16x8*)(kp + ks * 32), qf[ks], a);
        __builtin_amdgcn_s_setprio(0);
        st[kt] = a;
        asm volatile("" ::: "memory");
    }
    float mx = -3.0e38f;
#pragma unroll
    for (int kt = 0; kt < 8; ++kt)
#pragma unroll
        for (int i = 0; i < 16; ++i) mx = fmaxf(mx, st[kt][i]);
    mx = fmaxf(mx, __shfl_xor(mx, 32));
    float l = 0.f;
    bf16x8 pb[8][2];
#pragma unroll
    for (int kt = 0; kt < 8; ++kt)
#pragma unroll
        for (int s2 = 0; s2 < 2; ++s2) {
            float pv[8];
#pragma unroll
            for (int j = 0; j < 8; ++j) { pv[j] = __builtin_amdgcn_exp2f(st[kt][8 * s2 + j] - mx); l += pv[j]; }
            pb[kt][s2] = mk8(pk2(pv[0], pv[1]), pk2(pv[2], pv[3]), pk2(pv[4], pv[5]), pk2(pv[6], pv[7]));
        }
    l += __shfl_xor(l, 32);
    const float inv = 1.f / l;
    __syncthreads();
    xattn_stage<520>(lds, VT + (size_t)bh * 65536, tid);
    __syncthreads();
    bf16* orow = OO + (size_t)row * DM + h * 256;
#pragma unroll 1
    for (int dt = 0; dt < 8; ++dt) {
        f32x16 a;
#pragma unroll
        for (int i = 0; i < 16; ++i) a[i] = 0.f;
        const LAS unsigned char* vp = lds + (dt * 32 + l31) * 520 + hh * 8;
        __builtin_amdgcn_s_setprio(1);
#pragma unroll
        for (int kt = 0; kt < 8; ++kt)
#pragma unroll
            for (int s2 = 0; s2 < 2; ++s2) {
                const v2u lo = *(const LAS v2u*)(vp + (kt * 32 + 16 * s2) * 2), hi = *(const LAS v2u*)(vp + (kt * 32 + 16 * s2 + 8) * 2);
                a = MFMA32(mk8(lo.x, lo.y, hi.x, hi.y), pb[kt][s2], a);
            }
        __builtin_amdgcn_s_setprio(0);
        unsigned w[4][2];
#pragma unroll
        for (int g = 0; g < 4; ++g) { w[g][0] = pk2(a[4 * g] * inv, a[4 * g + 1] * inv); w[g][1] = pk2(a[4 * g + 2] * inv, a[4 * g + 3] * inv); }
#pragma unroll
        for (int k = 0; k < 4; k += 2) {
            const auto r0 = __builtin_amdgcn_permlane32_swap(w[k][0], w[k + 1][0], false, false);
            const auto r1 = __builtin_amdgcn_permlane32_swap(w[k][1], w[k + 1][1], false, false);
            *(v4u*)(orow + dt * 32 + 8 * k + 8 * hh) = (v4u){(unsigned)r0[0], (unsigned)r1[0], (unsigned)r0[1], (unsigned)r1[1]};
        }
    }
    __syncthreads();
}
__device__ __forceinline__ void xattn_phase(LAS unsigned char* lds, const bf16* QO, bf16* OO, const bf16* Kmem, const bf16* VT, int G, int bid, int tid, int wave, int lane) {
    for (int u = bid; u < 256; u += G) xattn_unit(lds, QO, OO, Kmem, VT, u >> 5, u & 31, tid, wave, lane);
}

#define RLX_AGENT __ATOMIC_RELAXED, __HIP_MEMORY_SCOPE_AGENT
#define XB_TMO      128
#define XB_XCNT(j)  (256  + 64 * (j))
#define XB_XSUB(j)  (1280 + 64 * (j))
#define XB_XGEN(j)  (2304 + 64 * (j))
#define XB_TOP      3328
#define XB_TOPGEN   3392
#define XCD_BAR_WORDS 3456
#define XB_SPIN_CAP (1u << 18)

__device__ __forceinline__ unsigned xb_ld(unsigned* p)              { return __hip_atomic_load(p, __ATOMIC_RELAXED, __HIP_MEMORY_SCOPE_AGENT); }
__device__ __forceinline__ unsigned xb_add(unsigned* p, unsigned v) { return __hip_atomic_fetch_add(p, v, __ATOMIC_RELAXED, __HIP_MEMORY_SCOPE_AGENT); }
__device__ __forceinline__ unsigned xb_xcc_id() { return (unsigned)__builtin_amdgcn_s_getreg((3 << 11) | 20) & 0xFu; }
#define XB_SPIN(cond, bar) do { unsigned _sp = 0; while (cond) { __builtin_amdgcn_s_sleep(1); \
    if ((++_sp & 255u) == 0u) { if (xb_ld(&(bar)[XB_TMO])) break; if (_sp > XB_SPIN_CAP) { atomicAdd(&(bar)[XB_TMO], 1u); break; } } } } while (0)

struct XcdBarrier {
    unsigned* bar; unsigned x;
    volatile LAS unsigned* st;
};

__device__ __forceinline__ XcdBarrier xcd_barrier_post(unsigned* bar, volatile LAS unsigned* st) {
    XcdBarrier b; b.bar = bar; b.x = xb_xcc_id(); b.st = st;
    if (threadIdx.x == 0) (void)xb_add(&bar[XB_XCNT(b.x)], 1u);
    return b;
}
__device__ __forceinline__ void xcd_barrier_complete(unsigned* bar, unsigned x, unsigned& nloc, unsigned& nx) {
    const unsigned G = gridDim.x * gridDim.y * gridDim.z;
    unsigned sum, cnt, mine, sp = 0u;
    for (;;) {
        sum = 0u; cnt = 0u; mine = 0u;
#pragma unroll
        for (unsigned j = 0; j < 16; ++j) { const unsigned c = xb_ld(&bar[XB_XCNT(j)]); sum += c; cnt += (c > 0u) ? 1u : 0u; mine = (j == x) ? c : mine; }
        if (sum == G) break;
        __builtin_amdgcn_s_sleep(1);
        if ((++sp & 255u) == 0u) { if (xb_ld(&bar[XB_TMO])) break; if (sp > XB_SPIN_CAP) { atomicAdd(&bar[XB_TMO], 1u); break; } }
    }
    nloc = mine > 0u ? mine : 1u; nx = cnt > 0u ? cnt : 1u;
}

__device__ __forceinline__ void xcd_barrier(const XcdBarrier& b) {
    asm volatile("s_waitcnt vmcnt(0)" ::: "memory");
    __syncthreads();
    if (threadIdx.x == 0) {
        unsigned* bar = b.bar;
        __builtin_amdgcn_s_waitcnt(0);
        unsigned nloc = b.st[0], nx = b.st[1];
        if (nloc == 0u) { xcd_barrier_complete(bar, b.x, nloc, nx); b.st[0] = nloc; b.st[1] = nx; }
        const unsigned old = xb_add(&bar[XB_XSUB(b.x)], 1u);
        const unsigned gen = old / nloc;
        if (old + 1u == (gen + 1u) * nloc) {
            __builtin_amdgcn_fence(__ATOMIC_RELEASE, "agent");
            asm volatile("s_waitcnt vmcnt(0)" ::: "memory");
            const unsigned og = xb_add(&bar[XB_TOP], 1u);
            const unsigned tg = og / nx;
            if (og + 1u == (tg + 1u) * nx) xb_add(&bar[XB_TOPGEN], 1u);
            else XB_SPIN(xb_ld(&bar[XB_TOPGEN]) == tg, bar);
            __builtin_amdgcn_fence(__ATOMIC_ACQUIRE, "agent");
            xb_add(&bar[XB_XGEN(b.x)], 1u);
            asm volatile("s_waitcnt vmcnt(0)" ::: "memory");
        } else {
            XB_SPIN(xb_ld(&bar[XB_TOPGEN]) == gen, bar);
            __builtin_amdgcn_fence(__ATOMIC_ACQUIRE, "agent");
            asm volatile("s_waitcnt vmcnt(0)" ::: "memory");
        }
    }
    __syncthreads();
}

constexpr int I_UP = 16 * 44, I_KV = 16 * 32, I_DN = 44 * 16, I_IN = 16 * 97, I_SQ = 16 * 16;
constexpr int N_EARLY = 2 * I_UP + I_KV, N_LATE = I_DN + I_IN + 3 * I_SQ + 2 * I_UP + I_DN;
struct Params { const float* in[26]; float* out; unsigned char* ws; };


__global__ void __launch_bounds__(512) fwd_kernel(Params p) {
    extern __shared__ __attribute__((aligned(16))) unsigned char lds_raw[];
    LAS unsigned char* lds = (LAS unsigned char*)lds_raw;
#define FRESH_TID() int tid = threadIdx.x; asm volatile("" : "+v"(tid)); const int lane = tid & 63, wave = __builtin_amdgcn_readfirstlane(tid >> 6); (void)lane; (void)wave
    const int G = gridDim.x, bid = blockIdx.x;
    unsigned char* ws = p.ws;
    float* rowss = (float*)(ws + WS_ROWSS); float* zbuf = (float*)(ws + WS_Z); float* decay = (float*)(ws + WS_DECAY);
    bf16* W1CAT = (bf16*)(ws + WS_W1CAT); bf16* WD1 = (bf16*)(ws + WS_WD1); bf16* WIN = (bf16*)(ws + WS_WIN); bf16* WZ = (bf16*)(ws + WS_WZ);
    bf16* WOUT = (bf16*)(ws + WS_WOUT); bf16* WQ = (bf16*)(ws + WS_WQ); bf16* WO = (bf16*)(ws + WS_WO); bf16* W2CAT = (bf16*)(ws + WS_W2CAT); bf16* WD2 = (bf16*)(ws + WS_WD2);
    bf16* KMEM = (bf16*)(ws + WS_KMEM); bf16* VTM = (bf16*)(ws + WS_VT); bf16* MIX = (bf16*)(ws + WS_MIX); bf16* RB = (bf16*)(ws + WS_R); bf16* XG = (bf16*)(ws + WS_XG);
    bf16* ST = (bf16*)p.out;
    const float* x = p.in[0]; float* out = p.out;
    volatile LAS unsigned* MISC = (volatile LAS unsigned*)(lds + LDS_MISC);
    if (threadIdx.x < 16) MISC[threadIdx.x] = 0u;
    __syncthreads();
    const XcdBarrier xbar = xcd_barrier_post((unsigned*)(ws + WS_BAR), MISC);

    {
        FRESH_TID();
        LAS float* scr = (LAS float*)(lds + wave * 16896);
        const int gw = bid * 8 + wave, NGW = G * 8;
        for (int it = gw; it < N_EARLY; it += NGW) {
            int r = it;
            if (r < I_UP) { const int kb = r / 44, n0 = (r % 44) * 64; tr_tile<64>(p.in[3], DFF, DM, kb * 64, n0, W1CAT + (size_t)((n0 >> 7) * 256 + (n0 & 127)) * DM, scr, lane); continue; } r -= I_UP;
            if (r < I_UP) { const int kb = r / 44, n0 = (r % 44) * 64; tr_tile<64>(p.in[4], DFF, DM, kb * 64, n0, W1CAT + (size_t)((n0 >> 7) * 256 + 128 + (n0 & 127)) * DM, scr, lane); continue; } r -= I_UP;
            { const int kb = r / 32, n0 = (r % 32) * 64; tr_tile<64>(p.in[19], 2 * DM, DM, kb * 64, n0, W1CAT + (size_t)(2 * DFF + n0) * DM, scr, lane); }
        }
        for (int m = gw * 2; m < MTOK + BATCH * NMEM; m += NGW * 2) {
            if (m < MTOK) norm_rows2_bf16(x + (size_t)m * DM, x + (size_t)(m + 1) * DM, p.in[2], XG + (size_t)m * DM, XG + (size_t)(m + 1) * DM, lane);
            else norm_rows2_bf16(p.in[1] + (size_t)(m - MTOK) * DM, p.in[1] + (size_t)(m + 1 - MTOK) * DM, p.in[17], XG + (size_t)m * DM, XG + (size_t)(m + 1) * DM, lane);
        }
        for (int i = bid * 512 + tid; i < 3 * MTOK; i += G * 512) rowss[i] = 0.f;
    }
    xcd_barrier(xbar);

    {
        pg8::Gemm g{XG, W1CAT, MTOK + 512, 2 * DFF + 2 * DM, DM};
        OrderUpKV S; S.base.init(MTOK, 2 * DFF, G, bid); S.extra = 16;
        EpiUp E{RB, nullptr, KMEM, VTM, 2 * DFF / 256};
        pg8::gemm_phase<EpiUp, OrderUpKV, true, true>(lds, g, S, E);
        constexpr int NU = 2 * DFF / 256 * (MTOK / 256) + 16;
        const int rem = NU % G, nsp = rem ? G - rem : G, si = rem ? bid - rem : bid;
        if (si >= 0) {
            FRESH_TID();
            LAS float* scr = (LAS float*)(lds + wave * 16896);
            for (int it = si * 8 + wave; it < N_LATE; it += nsp * 8) {
                int r = it;
                if (r < I_DN) { const int kb = r / 16, n0 = (r % 16) * 64; tr_tile<64>(p.in[5], DM, DFF, kb * 64, n0, WD1 + (size_t)n0 * DFF, scr, lane); continue; } r -= I_DN;
                if (r < I_IN) { const int kb = r / 97, nb = r % 97, n0 = nb * 32;
                    bf16* dst = nb < 48 ? WIN + (size_t)n0 * DM : (nb == 48 ? WZ : WIN + (size_t)(n0 - 32) * DM);
                    tr_tile<32>(p.in[7], DIN, DM, kb * 64, n0, dst, scr, lane, p.in[6]); continue; } r -= I_IN;
                if (r < I_SQ) { const int kb = r / 16, n0 = (r % 16) * 64; tr_tile<64>(p.in[15], DM, DM, kb * 64, n0, WOUT + (size_t)n0 * DM, scr, lane); continue; } r -= I_SQ;
                if (r < I_SQ) { const int kb = r / 16, n0 = (r % 16) * 64; tr_tile<64>(p.in[18], DM, DM, kb * 64, n0, WQ + (size_t)n0 * DM, scr, lane, p.in[16]); continue; } r -= I_SQ;
                if (r < I_SQ) { const int kb = r / 16, n0 = (r % 16) * 64; tr_tile<64>(p.in[20], DM, DM, kb * 64, n0, WO + (size_t)n0 * DM, scr, lane); continue; } r -= I_SQ;
                if (r < I_UP) { const int kb = r / 44, n0 = (r % 44) * 64; tr_tile<64>(p.in[22], DFF, DM, kb * 64, n0, W2CAT + (size_t)((n0 >> 7) * 256 + (n0 & 127)) * DM, scr, lane, p.in[21]); continue; } r -= I_UP;
                if (r < I_UP) { const int kb = r / 44, n0 = (r % 44) * 64; tr_tile<64>(p.in[23], DFF, DM, kb * 64, n0, W2CAT + (size_t)((n0 >> 7) * 256 + 128 + (n0 & 127)) * DM, scr, lane, p.in[21]); continue; } r -= I_UP;
                { const int kb = r / 16, n0 = (r % 16) * 64; tr_tile<64>(p.in[24], DM, DFF, kb * 64, n0, WD2 + (size_t)n0 * DFF, scr, lane); }
            }
        }
    }
    xcd_barrier(xbar);
    {
        pg8::Gemm g{RB, WD1, MTOK, DM, DFF};
        pg8::StaticOrder S; S.init(MTOK, DM, G, bid);
        EpiResB E{x, XG, rowss, 0.5f};
        pg8::gemm_phase<EpiResB, pg8::StaticOrder, true, true>(lds, g, S, E);
    }
    xcd_barrier(xbar);
    {
        {
        pg8::Gemm g{XG, WIN, MTOK, NPROJ, DM};
        pg8::StaticOrder S; S.init(MTOK, NPROJ, G, bid);
        EpiScale E{RB, NPROJ, rowss, 1.f, true};
        pg8::gemm_phase<EpiScale, pg8::StaticOrder, true, true>(lds, g, S, E);
        }
        FRESH_TID();
        const int fr = lane & 15, fq = lane >> 4;
        for (int rb = bid; rb < MTOK / 64; rb += G) {
            const int row0 = rb * 64 + (wave >> 1) * 16, zc0 = (wave & 1) * 16;
            f32x4 acc0 = {0.f, 0.f, 0.f, 0.f}, acc1 = {0.f, 0.f, 0.f, 0.f};
            const float rsq = rowss[row0 + fr];
#pragma unroll 1
            for (int half = 0; half < 2; ++half) {
                v4u rg[12];
#pragma unroll
                for (int i = 0; i < 12; ++i) {
                    const int c = tid + 512 * i, row = c >> 6, c16 = c & 63;
                    const bf16* src = (row < 64 ? XG + (size_t)(rb * 64 + row) * DM : WZ + (size_t)(row - 64) * DM) + half * 512 + c16 * 8;
                    rg[i] = *(const v4u*)src;
                }
#pragma unroll
                for (int i = 0; i < 12; ++i) { const int c = tid + 512 * i; *(LAS v4u*)(lds + (c >> 6) * 1040 + (c & 63) * 16) = rg[i]; }
                __syncthreads();
                const LAS unsigned char* ap = lds + (64 + zc0 + fr) * 1040 + fq * 16; const LAS unsigned char* bp = lds + ((wave >> 1) * 16 + fr) * 1040 + fq * 16;
#pragma unroll
                for (int i = 0; i < 16; i += 2) {
                    acc0 = MFMA16(*(const LAS bf16x8*)(ap + i * 64), *(const LAS bf16x8*)(bp + i * 64), acc0);
                    acc1 = MFMA16(*(const LAS bf16x8*)(ap + (i + 1) * 64), *(const LAS bf16x8*)(bp + (i + 1) * 64), acc1);
                }
                __syncthreads();
            }
            const float rs = rsqrtf(rsq * (1.f / DM) + EPS);
            *(f32x4*)(zbuf + (size_t)(row0 + fr) * 32 + zc0 + fq * 4) = (acc0 + acc1) * rs;
        }
    }
    xcd_barrier(xbar);
    { FRESH_TID(); gla_g1(lds, zbuf, RB, p.in[8], p.in[9], p.in[10], p.in[11], decay, ST, p.in[13], p.in[14], MIX, G, bid, tid, wave, lane); }
    xcd_barrier(xbar);
    { FRESH_TID(); gla_g2(ST, decay, G, bid, tid); }
    xcd_barrier(xbar);
    { FRESH_TID(); gla_g3(lds, zbuf, RB, p.in[8], p.in[9], p.in[10], p.in[11], ST, p.in[12], MIX, G, bid, tid, wave, lane); }
    xcd_barrier(xbar);
    {
        pg8::Gemm g{MIX, WOUT, MTOK, DM, DM};
        pg8::StaticOrder S; S.init(MTOK, DM, G, bid);
        EpiResB E{nullptr, XG, rowss + MTOK, 1.f};
        pg8::gemm_phase<EpiResB, pg8::StaticOrder, true, true>(lds, g, S, E);
    }
    xcd_barrier(xbar);
    {
        pg8::Gemm g{XG, WQ, MTOK, DM, DM};
        pg8::StaticOrder S; S.init(MTOK, DM, G, bid);
        EpiScale E{MIX, DM, rowss + MTOK, 0.0625f * 1.4426950408889634f, false};
        pg8::gemm_phase<EpiScale, pg8::StaticOrder, true, true>(lds, g, S, E);
    }
    xcd_barrier(xbar);
    { FRESH_TID(); xattn_phase(lds, MIX, RB, KMEM, VTM, G, bid, tid, wave, lane); }
    xcd_barrier(xbar);
    {
        pg8::Gemm g{RB, WO, MTOK, DM, DM};
        pg8::StaticOrder S; S.init(MTOK, DM, G, bid);
        EpiResB E{nullptr, XG, rowss + 2 * MTOK, 1.f};
        pg8::gemm_phase<EpiResB, pg8::StaticOrder, true, true>(lds, g, S, E);
    }
    xcd_barrier(xbar);
    {
        pg8::Gemm g{XG, W2CAT, MTOK, 2 * DFF, DM};
        pg8::StaticOrder S; S.init(MTOK, 2 * DFF, G, bid);
        EpiUp E{RB, rowss + 2 * MTOK, nullptr, nullptr, 2 * DFF / 256};
        pg8::gemm_phase<EpiUp, pg8::StaticOrder, true, true>(lds, g, S, E);
    }
    xcd_barrier(xbar);
    if (G == MTOK / 256 * (DM / 256)) {
        pg8::Gemm g{RB, WD2, MTOK, DM, DFF};
        pg8::StaticOrder S; S.init(MTOK, DM, G, bid);
        EpiResNorm E{XG, out, p.in[25], 0.5f, (float*)(ws + WS_PART), (unsigned*)(ws + WS_BAR + 16384)};
        pg8::gemm_phase<EpiResNorm, pg8::StaticOrder, false, true>(lds, g, S, E);
    } else {
        {
            pg8::Gemm g{RB, WD2, MTOK, DM, DFF};
            pg8::StaticOrder S; S.init(MTOK, DM, G, bid);
            EpiResF E{XG, out, 0.5f};
            pg8::gemm_phase<EpiResF, pg8::StaticOrder, true, true>(lds, g, S, E);
        }
        xcd_barrier(xbar);
        {
            FRESH_TID();
            const int gw = bid * 8 + wave, NGW = G * 8;
            for (int m = gw; m < MTOK; m += NGW) {
                f32x4* xr = (f32x4*)(out + (size_t)m * DM) + lane; const f32x4* gr = (const f32x4*)p.in[25] + lane;
                f32x4 v[4]; float s = 0.f;
#pragma unroll
                for (int j = 0; j < 4; ++j) { v[j] = xr[64 * j]; s += (v[j][0] * v[j][0] + v[j][1] * v[j][1]) + (v[j][2] * v[j][2] + v[j][3] * v[j][3]); }
                const float rs = rsqrtf(wave_sum(s) * (1.f / DM) + EPS);
#pragma unroll
                for (int j = 0; j < 4; ++j) xr[64 * j] = v[j] * rs * gr[64 * j];
            }
        }
    }
}

extern "C" void kernel_launch(void* const* d_in, const int* in_sizes, int n_in, void* d_out, int out_size, void* d_ws, size_t ws_size, hipStream_t stream) {
    static int grid_blocks = 0;
    if (!grid_blocks) {
        if (n_in != 26 || out_size != MTOK * DM || ws_size < WS_END) { fprintf(stderr, "kernel_launch: unexpected shapes n_in=%d out=%d ws=%zu\n", n_in, out_size, ws_size); grid_blocks = -1; return; }
        int dev = 0, cus = 0, per_cu = 0;
        hipGetDevice(&dev);
        hipDeviceGetAttribute(&cus, hipDeviceAttributeMultiprocessorCount, dev);
        hipFuncSetAttribute((const void*)fwd_kernel, hipFuncAttributeMaxDynamicSharedMemorySize, LDS_BYTES);
        hipOccupancyMaxActiveBlocksPerMultiprocessor(&per_cu, (const void*)fwd_kernel, 512, LDS_BYTES);
        if (per_cu < 1) { fprintf(stderr, "kernel_launch: occupancy query says %d blocks/CU\n", per_cu); per_cu = 1; }
        grid_blocks = cus * per_cu;
    }
    if (grid_blocks < 0) return;
    if (hipMemsetAsync((char*)d_ws + WS_BAR, 0, 32768, stream) != hipSuccess) { fprintf(stderr, "kernel_launch: memset failed\n"); return; }
    Params p{};
    for (int i = 0; i < 26; ++i) p.in[i] = (const float*)d_in[i];
    p.out = (float*)d_out; p.ws = (unsigned char*)d_ws;
    void* args[] = {&p};
    hipError_t e = hipLaunchCooperativeKernel((const void*)fwd_kernel, dim3(grid_blocks), dim3(512), args, LDS_BYTES, stream);
    if (e != hipSuccess) fprintf(stderr, "cooperative launch failed: %s (grid %d)\n", hipGetErrorString(e), grid_blocks);
}
```
